# Optimizing an MI355X kernel written in HIP

```python
import jax, jax.numpy as jnp
from jax import lax
import numpy as np


D_MODEL = 4096
BATCH = 4
SEQ = 2048
DEPTH = 1
DEC_BATCH = 8
DEC_SEQ = 32
PAST_LEN = 1024

CHUNK = 64
N_META = 16
POOL_WIDTH = D_MODEL // 2
POOL_WINDOWS = (2, 4, 8, 16)
N_POOL_GROUPS = 4
POOL_GROUP = POOL_WIDTH // N_POOL_GROUPS
POOL_STATE = max(POOL_WINDOWS) - 1
LRU_WIDTH = D_MODEL
N_LRU_BLOCKS = 16
LRU_BLOCK = LRU_WIDTH // N_LRU_BLOCKS
CONV_WIDTH = 4
LRU_C = 8.0
D_FF = 256 * ((8 * D_MODEL // 3 + 255) // 256)
IN_WIDTH = POOL_WIDTH + 2 * LRU_WIDTH
N_BRANCH = 2
ALPHA = (2.0 * DEPTH) ** 0.25
BETA = (8.0 * DEPTH) ** -0.25
LN_EPS = 1e-5

kernel_name = "hybrid_pool_rglru_streaming_encoder_step"


def layer_norm(x, g, b):
    xf = x.astype(jnp.float32)
    mu = jnp.mean(xf, axis=-1, keepdims=True)
    var = jnp.mean(jnp.square(xf - mu), axis=-1, keepdims=True)
    return ((xf - mu) * lax.rsqrt(var + LN_EPS) * g.astype(jnp.float32) + b.astype(jnp.float32)).astype(x.dtype)


def swiglu(x, w_in, w_out):
    gate, up = jnp.split(x @ w_in, 2, axis=-1)
    return (jax.nn.silu(gate) * up) @ w_out


def multiscale_pool(u_ext, n_hist, w_pool, pool_scale):
    B, L, _ = u_ext.shape
    T = L - POOL_STATE
    cs = jnp.cumsum(u_ext.astype(jnp.float32), axis=1)
    cs = jnp.pad(cs, ((0, 0), (1, 0), (0, 0)))
    pos = jnp.arange(T, dtype=jnp.float32)
    means = []
    for g, w in enumerate(POOL_WINDOWS):
        lo, hi = g * POOL_GROUP, (g + 1) * POOL_GROUP
        s = cs[:, POOL_STATE + 1:, lo:hi] - cs[:, POOL_STATE + 1 - w:POOL_STATE + 1 - w + T, lo:hi]
        cnt = jnp.minimum(float(w), n_hist + 1.0 + pos)
        means.append(s / cnt[None, :, None])
    d = jnp.concatenate(means, axis=-1) - u_ext[:, POOL_STATE:].astype(jnp.float32)
    d = d.astype(u_ext.dtype).reshape(B, T, N_POOL_GROUPS, POOL_GROUP)
    y = jnp.einsum('btgi,gio->btgo', d, w_pool).reshape(B, T, POOL_WIDTH)
    return y * pool_scale


def causal_conv(u_ext, w, b):
    T = u_ext.shape[1] - (CONV_WIDTH - 1)
    out = b
    for k in range(CONV_WIDTH):
        out = out + u_ext[:, k:k + T] * w[k]
    return out


def rg_lru(xc, h0, w_a, b_a, w_x, b_x, lam):
    B, T, R = xc.shape
    xb = xc.reshape(B, T, N_LRU_BLOCKS, LRU_BLOCK)
    r = jax.nn.sigmoid(jnp.einsum('btni,nio->btno', xb, w_a).reshape(B, T, R) + b_a)
    i = jax.nn.sigmoid(jnp.einsum('btni,nio->btno', xb, w_x).reshape(B, T, R) + b_x)
    log_a = -LRU_C * r.astype(jnp.float32) * jax.nn.softplus(-lam.astype(jnp.float32))
    a = jnp.exp(log_a)
    mult = jnp.sqrt(-jnp.expm1(2.0 * log_a))
    bx = mult * (i * xc).astype(jnp.float32)

    def step(h, ab):
        a_t, b_t = ab
        h = a_t * h + b_t
        return h, h

    h_last, hs = lax.scan(step, h0.astype(jnp.float32), (jnp.swapaxes(a, 0, 1), jnp.swapaxes(bx, 0, 1)))
    return jnp.swapaxes(hs, 0, 1).astype(xc.dtype), h_last


def mixer(x, hist_pool, hist_conv, h0, n_hist, p):
    B, T, _ = x.shape
    z = x @ p['w_in']
    u_pool = z[..., :POOL_WIDTH]
    u_lru = z[..., POOL_WIDTH:POOL_WIDTH + LRU_WIDTH]
    u_gate = z[..., POOL_WIDTH + LRU_WIDTH:]
    pool_ext = jnp.concatenate([hist_pool.astype(z.dtype), u_pool], axis=1)
    y_a = multiscale_pool(pool_ext, n_hist, p['w_pool'], p['pool_scale'])
    conv_ext = jnp.concatenate([hist_conv.astype(z.dtype), u_lru], axis=1)
    xc = causal_conv(conv_ext, p['conv_w'], p['conv_b'])
    hs, h_last = rg_lru(xc, h0, p['lru_w_a'], p['lru_b_a'], p['lru_w_x'], p['lru_b_x'], p['lru_lambda'])
    y_b = hs * jax.nn.gelu(u_gate)
    gates = jax.nn.sigmoid(x @ p['w_merge_gate'] + p['b_merge_gate']).reshape(B, T, N_BRANCH, D_MODEL)
    m = gates[:, :, 0] * (y_a @ p['w_up_pool']) + gates[:, :, 1] * (y_b @ p['w_up_lru'])
    out = m @ p['w_out']
    return out, pool_ext[:, -POOL_STATE:], conv_ext[:, -(CONV_WIDTH - 1):], h_last


def layer(x, hist_pool, hist_conv, h0, n_hist, p):
    x = layer_norm(ALPHA * x + 0.5 * swiglu(x, p['ffn1_w_in'], p['ffn1_w_out']), p['ln1_g'], p['ln1_b'])
    mix, new_pool, new_conv, new_h = mixer(x, hist_pool, hist_conv, h0, n_hist, p)
    x = layer_norm(ALPHA * x + mix, p['ln2_g'], p['ln2_b'])
    x = layer_norm(ALPHA * x + 0.5 * swiglu(x, p['ffn2_w_in'], p['ffn2_w_out']), p['ln3_g'], p['ln3_b'])
    return x, new_pool, new_conv, new_h


def setup_inputs(seed: int = 0) -> dict:
    key = jax.random.key(seed)
    ks = jax.random.split(key, 40)
    f32 = jnp.float32

    def nrm(k, shape, scale):
        return jax.random.normal(k, shape, f32) * scale

    a0 = jax.random.uniform(ks[14], (DEPTH, LRU_WIDTH), f32, 0.9, 0.999)
    return {
        'x_prompt': nrm(ks[0], (BATCH, SEQ, D_MODEL), 1.0),
        'x_sample': nrm(ks[1], (DEC_BATCH, DEC_SEQ, D_MODEL), 1.0),
        'state_pool': nrm(ks[2], (DEPTH, DEC_BATCH, POOL_STATE, POOL_WIDTH), 1.0),
        'state_conv': nrm(ks[3], (DEPTH, DEC_BATCH, CONV_WIDTH - 1, LRU_WIDTH), 1.0),
        'state_lru': nrm(ks[4], (DEPTH, DEC_BATCH, LRU_WIDTH), 0.5),
        'meta_tokens': nrm(ks[5], (N_META, D_MODEL), 1.0),
        'ffn1_w_in': nrm(ks[6], (DEPTH, D_MODEL, 2 * D_FF), D_MODEL ** -0.5),
        'ffn1_w_out': nrm(ks[7], (DEPTH, D_FF, D_MODEL), BETA * D_FF ** -0.5),
        'ln1_g': 1.0 + nrm(ks[8], (DEPTH, D_MODEL), 0.01),
        'ln1_b': nrm(ks[9], (DEPTH, D_MODEL), 0.01),
        'w_in': nrm(ks[10], (DEPTH, D_MODEL, IN_WIDTH), D_MODEL ** -0.5),
        'w_pool': nrm(ks[11], (DEPTH, N_POOL_GROUPS, POOL_GROUP, POOL_GROUP), POOL_GROUP ** -0.5),
        'pool_scale': 1.0 + nrm(ks[12], (DEPTH, POOL_WIDTH), 0.1),
        'conv_w': nrm(ks[13], (DEPTH, CONV_WIDTH, LRU_WIDTH), CONV_WIDTH ** -0.5),
        'conv_b': nrm(ks[15], (DEPTH, LRU_WIDTH), 0.01),
        'lru_w_a': nrm(ks[16], (DEPTH, N_LRU_BLOCKS, LRU_BLOCK, LRU_BLOCK), LRU_BLOCK ** -0.5),
        'lru_b_a': nrm(ks[17], (DEPTH, LRU_WIDTH), 0.01),
        'lru_w_x': nrm(ks[18], (DEPTH, N_LRU_BLOCKS, LRU_BLOCK, LRU_BLOCK), LRU_BLOCK ** -0.5),
        'lru_b_x': nrm(ks[19], (DEPTH, LRU_WIDTH), 0.01),
        'lru_lambda': jnp.log(a0) - jnp.log1p(-a0),
        'w_merge_gate': nrm(ks[20], (DEPTH, D_MODEL, N_BRANCH * D_MODEL), D_MODEL ** -0.5),
        'b_merge_gate': nrm(ks[21], (DEPTH, N_BRANCH * D_MODEL), 0.01),
        'w_up_pool': nrm(ks[22], (DEPTH, POOL_WIDTH, D_MODEL), POOL_WIDTH ** -0.5),
        'w_up_lru': nrm(ks[23], (DEPTH, LRU_WIDTH, D_MODEL), LRU_WIDTH ** -0.5),
        'w_out': nrm(ks[24], (DEPTH, D_MODEL, D_MODEL), BETA * D_MODEL ** -0.5),
        'ln2_g': 1.0 + nrm(ks[25], (DEPTH, D_MODEL), 0.01),
        'ln2_b': nrm(ks[26], (DEPTH, D_MODEL), 0.01),
        'ffn2_w_in': nrm(ks[27], (DEPTH, D_MODEL, 2 * D_FF), D_MODEL ** -0.5),
        'ffn2_w_out': nrm(ks[28], (DEPTH, D_FF, D_MODEL), BETA * D_FF ** -0.5),
        'ln3_g': 1.0 + nrm(ks[29], (DEPTH, D_MODEL), 0.01),
        'ln3_b': nrm(ks[30], (DEPTH, D_MODEL), 0.01),
    }


def reference(x_prompt, x_sample, state_pool, state_conv, state_lru, meta_tokens,
              ffn1_w_in, ffn1_w_out, ln1_g, ln1_b, w_in, w_pool, pool_scale, conv_w, conv_b,
              lru_w_a, lru_b_a, lru_w_x, lru_b_x, lru_lambda, w_merge_gate, b_merge_gate,
              w_up_pool, w_up_lru, w_out, ln2_g, ln2_b, ffn2_w_in, ffn2_w_out, ln3_g, ln3_b):
    bp = x_prompt.shape[0]
    meta = jnp.broadcast_to(meta_tokens[None].astype(x_prompt.dtype), (bp, N_META, D_MODEL))
    xp = jnp.concatenate([meta, x_prompt], axis=1)
    xs = x_sample
    zero_pool = jnp.zeros((bp, POOL_STATE, POOL_WIDTH), x_prompt.dtype)
    zero_conv = jnp.zeros((bp, CONV_WIDTH - 1, LRU_WIDTH), x_prompt.dtype)
    zero_h = jnp.zeros((bp, LRU_WIDTH), jnp.float32)
    pool_p, conv_p, lru_p, pool_s, conv_s, lru_s = [], [], [], [], [], []
    for l in range(DEPTH):
        p = {
            'ffn1_w_in': ffn1_w_in[l], 'ffn1_w_out': ffn1_w_out[l], 'ln1_g': ln1_g[l], 'ln1_b': ln1_b[l],
            'w_in': w_in[l], 'w_pool': w_pool[l], 'pool_scale': pool_scale[l],
            'conv_w': conv_w[l], 'conv_b': conv_b[l],
            'lru_w_a': lru_w_a[l], 'lru_b_a': lru_b_a[l], 'lru_w_x': lru_w_x[l], 'lru_b_x': lru_b_x[l],
            'lru_lambda': lru_lambda[l], 'w_merge_gate': w_merge_gate[l], 'b_merge_gate': b_merge_gate[l],
            'w_up_pool': w_up_pool[l], 'w_up_lru': w_up_lru[l], 'w_out': w_out[l],
            'ln2_g': ln2_g[l], 'ln2_b': ln2_b[l],
            'ffn2_w_in': ffn2_w_in[l], 'ffn2_w_out': ffn2_w_out[l], 'ln3_g': ln3_g[l], 'ln3_b': ln3_b[l],
        }
        xp, np_pool, np_conv, np_h = layer(xp, zero_pool, zero_conv, zero_h, 0, p)
        xs, ns_pool, ns_conv, ns_h = layer(xs, state_pool[l], state_conv[l], state_lru[l], POOL_STATE, p)
        pool_p.append(np_pool); conv_p.append(np_conv); lru_p.append(np_h)
        pool_s.append(ns_pool); conv_s.append(ns_conv); lru_s.append(ns_h)
    y_prompt = xp[:, N_META:]
    y_sample = xs
    new_pool_prompt = jnp.stack(pool_p)
    new_conv_prompt = jnp.stack(conv_p)
    new_lru_prompt = jnp.stack(lru_p)
    new_pool_sample = jnp.stack(pool_s)
    new_conv_sample = jnp.stack(conv_s)
    new_lru_sample = jnp.stack(lru_s)
    return (y_prompt, y_sample, new_pool_prompt, new_conv_prompt, new_lru_prompt, new_pool_sample, new_conv_sample, new_lru_sample)
```

```cpp
#include <hip/hip_runtime.h>
#include <cstdio>
#include <cstdint>

__device__ __forceinline__ int lane_now() { int l; asm volatile("v_mbcnt_lo_u32_b32 %0, -1, 0\n\tv_mbcnt_hi_u32_b32 %0, -1, %0" : "=v"(l)); return l; }
namespace pg8 {
#define PG8_LAS __attribute__((address_space(3)))
typedef unsigned short bf16_t;
typedef short bf16x8 __attribute__((ext_vector_type(8)));
typedef float f32x4 __attribute__((ext_vector_type(4)));
typedef unsigned u32x4 __attribute__((ext_vector_type(4)));
constexpr int BM = 256, BK = 64, HALF = 128, HTB = HALF * BK * 2  , STAGE_BYTES = 8 * HTB, NXCD = 8, WGM = 8;

__host__ __device__ __forceinline__ int lds_byte(int r, int c) { const int st = (r >> 4) * 2 + (c >> 5), rr = r & 15, cc = c & 31, ob = rr * 64 + cc * 2; return st * 1024 + (ob ^ (((ob >> 9) & 1) << 5)); }
__host__ __device__ __forceinline__ void stage_rc(int b, int& R, int& C) { const int st = b / 1024, sb = b % 1024, swz = sb ^ (((sb >> 9) & 1) << 5); R = (st >> 1) * 16 + swz / 64; C = (st & 1) * 32 + (swz % 64) / 2; }
__host__ __device__ __forceinline__ int perm32(int rho) { const int n = rho >> 4, i = rho & 15; return 8 * (i >> 2) + 4 * n + (i & 3); }

struct Unit { int pm, pn, kt0, nk, slab; };
struct Gemm { const bf16_t* A; const bf16_t* Bt; int lda, ldb, K, tpg, agoff; };

struct StaticOrder {
    int nM, nN, nwg, G, c;
    __host__ __device__ void init(int M, int N, int G_, int c_) { nM = M / BM; nN = N / BM; nwg = nM * nN; G = G_; c = c_; }
    __host__ __device__ bool next(int i, Unit& u) const { return at((long)i * G + c, u); }
    __host__ __device__ bool at(long L, Unit& u) const {
        if (L >= nwg) return false;
        int wgid = (int)L; { const int q = nwg / NXCD, r = nwg % NXCD, xcd = wgid % NXCD, off = wgid / NXCD; wgid = (xcd < r ? xcd * (q + 1) : r * (q + 1) + (xcd - r) * q) + off; }
        const int nig = WGM * nN, gid = wgid / nig, fm = gid * WGM, gsz = (nM - fm) < WGM ? (nM - fm) : WGM;
        u.pm = fm + ((wgid % nig) % gsz); u.pn = (wgid % nig) / gsz; u.kt0 = 0; u.nk = -1; u.slab = -1; return true;
    }
    __device__ __forceinline__ void a_ready(const Unit&) const {}
    __device__ __forceinline__ void done(const Unit&) const {}
};

typedef float f32x2_t __attribute__((ext_vector_type(2)));
typedef __bf16 bf16x2_t __attribute__((ext_vector_type(2)));
struct SplitTailOrder {
    StaticOrder so; int nN, base, rem2;
    __host__ __device__ void init(int N, int ktiles, int G_, int c_) { so.init(32 * BM, N, G_, c_); nN = N / BM; base = (ktiles / 8) & ~1; rem2 = (ktiles - 8 * base) / 2; }
    __host__ __device__ bool next(int i, Unit& u) const {
        const long L = (long)i * so.G + so.c;
        if (L < so.nwg) return so.next(i, u);
        const int Lp = (int)(L - so.nwg); if (Lp >= 2 * nN * 8) return false;
        const int ks = Lp & 7, tile = Lp >> 3;
        u.pm = 32 + tile / nN; u.pn = tile % nN; u.kt0 = ks * base + 2 * (ks < rem2 ? ks : rem2); u.nk = base + (ks < rem2 ? 2 : 0); u.slab = tile * 8 + ks; return true;
    }
    __device__ __forceinline__ void a_ready(const Unit&) const {}
    __device__ __forceinline__ void done(const Unit&) const {}
};

struct Z8Order {
    StaticOrder sa, sb; int G, c;
    __host__ __device__ void init(int G_, int c_) { G = G_; c = c_; sa.init(34 * BM, 16 * BM, G_, 0); sb.init(29 * BM, 24 * BM, G_, 0); }
    __host__ __device__ bool next(int i, Unit& u) const {
        const long L = (long)i * G + c;
        if (L < sa.nwg) { sa.at(L, u); u.pn += 24; return true; }
        if (!sb.at(L - sa.nwg, u)) return false;
        u.pm += (u.pm >= 8) ? 1 : 0; u.pm += (u.pm >= 16) ? 1 : 0; u.pm += (u.pm >= 24) ? 1 : 0; return true;
    }
    __device__ __forceinline__ void a_ready(const Unit&) const {}
    __device__ __forceinline__ void done(const Unit&) const {}
};
struct ZbOrder {
    StaticOrder so;
    __host__ __device__ void init(int G_, int c_) { so.init(5 * BM, 24 * BM, G_, c_); }
    __host__ __device__ bool next(int i, Unit& u) const { if (!so.next(i, u)) return false; u.pm = u.pm < 3 ? 8 * (u.pm + 1) : 29 + u.pm; return true; }
    __device__ __forceinline__ void a_ready(const Unit&) const {}
    __device__ __forceinline__ void done(const Unit&) const {}
};

__device__ __forceinline__ unsigned cvt_pk_bf16(float lo, float hi) { const f32x2_t v = {lo, hi}; return __builtin_bit_cast(unsigned, __builtin_convertvector(v, bf16x2_t)); }

typedef short s16x16 __attribute__((ext_vector_type(16)));
typedef int i32x8 __attribute__((ext_vector_type(8)));
typedef int i32x4 __attribute__((ext_vector_type(4)));
template <class Epi, class Sched, bool ALIGN_EPI = false, bool SP2 = false, int QT = 0>
__device__ __forceinline__ void gemm_phase(PG8_LAS unsigned char* lds, const Gemm g, const Sched& S, const Epi& E, const int wid  ) {
    const int lane = lane_now(), tid = (wid << 6) | lane, wr = wid >> 2, wc = wid & 3, fr = lane & 15, fq = lane >> 4;
    int Kop = g.K; asm volatile("" : "+s"(Kop));
    const int K = Kop, nt_full = K / BK;
    unsigned voffA[2], voffB[2];
#pragma unroll
    for (int i = 0; i < 2; ++i) { int R, C; stage_rc(tid * 16 + i * 8192, R, C); const int Rb = Epi::PERM ? ((R & ~31) + perm32(R & 31)) : R;
        voffA[i] = (unsigned)(R * g.lda + C) * 2u; voffB[i] = (unsigned)(Rb * g.ldb + C) * 2u; }
    const __amdgpu_buffer_rsrc_t rsA = __builtin_amdgcn_make_buffer_rsrc((void*)g.A, (short)0, 0x7fffffff, 0x00020000), rsB = __builtin_amdgcn_make_buffer_rsrc((void*)g.Bt, (short)0, 0x7fffffff, 0x00020000);
    const unsigned kstep = (unsigned)(BK * 2);
    const unsigned hstepA = (unsigned)HALF * g.lda * 2, hstepB = (unsigned)HALF * g.ldb * 2;
    const unsigned tstepA = 2 * hstepA, tstepB = 2 * hstepB;
    const unsigned ldsw = (unsigned)wid * 1024u;
    const int aoff = lds_byte(wr * 64 + fr, fq * 8), boff = lds_byte(wc * 32 + fr, fq * 8);
#define PG8_UA(u) ((unsigned)(u).pm * tstepA + (unsigned)((u).pn / g.tpg) * (unsigned)g.agoff * 2u)
#define PG8_UB(u) ((unsigned)(u).pn * tstepB)
#define PG8_SA(b, h) (((b) * 2 + (h)) * HTB)
#define PG8_SB(b, h) ((4 + (b) * 2 + (h)) * HTB)
#define PG8_STAGE(bufoff, soff, voff, rs) do { _Pragma("unroll") for (int _i = 0; _i < 2; ++_i) \
        __builtin_amdgcn_raw_ptr_buffer_load_lds(rs, (PG8_LAS unsigned*)(lds + (bufoff) + ldsw + _i * 8192), 16, (voff)[_i], (int)(soff), 0, 0); } while (0)
#define PG8_LDA(dst, b, h) do { _Pragma("unroll") for (int m = 0; m < 4; ++m) _Pragma("unroll") for (int k = 0; k < 2; ++k) dst[m][k] = *(const PG8_LAS bf16x8*)(lds + PG8_SA(b, h) + aoff + m * 2048 + k * 1024); } while (0)
#define PG8_LDB(dst, b, h) do { _Pragma("unroll") for (int n = 0; n < 2; ++n) _Pragma("unroll") for (int k = 0; k < 2; ++k) dst[n][k] = *(const PG8_LAS bf16x8*)(lds + PG8_SB(b, h) + boff + n * 2048 + k * 1024); } while (0)
#define PG8_CAT(a, b) __builtin_bit_cast(i32x8, __builtin_shufflevector(a, b, 0, 1, 2, 3, 4, 5, 6, 7, 8, 9, 10, 11, 12, 13, 14, 15))
#define PG8_MMA(ai, bj, At, Bt) do { __builtin_amdgcn_s_setprio(1); if constexpr (QT == 1) { _Pragma("unroll") for (int m = 0; m < 4; ++m) _Pragma("unroll") for (int n = 0; n < 2; ++n) \
        acc[ai][bj][m][n] = __builtin_amdgcn_mfma_scale_f32_16x16x128_f8f6f4(PG8_CAT(Bt[n][0], Bt[n][1]), PG8_CAT(At[m][0], At[m][1]), acc[ai][bj][m][n], 0, 0, 0, 127, 0, 127); } else if constexpr (QT == 2) { \
        _Pragma("unroll") for (int m = 0; m < 4; ++m) _Pragma("unroll") for (int n = 0; n < 2; ++n) _Pragma("unroll") for (int k = 0; k < 2; ++k) \
        acc[ai][bj][m][n] = __builtin_bit_cast(f32x4, __builtin_amdgcn_mfma_i32_16x16x64_i8(__builtin_bit_cast(i32x4, Bt[n][k]), __builtin_bit_cast(i32x4, At[m][k]), __builtin_bit_cast(i32x4, acc[ai][bj][m][n]), 0, 0, 0)); } else { \
        _Pragma("unroll") for (int m = 0; m < 4; ++m) _Pragma("unroll") for (int n = 0; n < 2; ++n) _Pragma("unroll") for (int k = 0; k < 2; ++k) \
        acc[ai][bj][m][n] = __builtin_amdgcn_mfma_f32_16x16x32_bf16(Bt[n][k], At[m][k], acc[ai][bj][m][n], 0, 0, 0); } __builtin_amdgcn_s_setprio(0); } while (0)
#define PG8_WAIT_V(n) asm volatile("s_waitcnt vmcnt(" #n ")" ::: "memory")
#define PG8_WAIT_L(n) asm volatile("s_waitcnt lgkmcnt(" #n ")" ::: "memory")
#define PG8_BAR __builtin_amdgcn_s_barrier()
#define PG8_SCHED __builtin_amdgcn_sched_barrier(0)
    Unit cur, nxt; int ui = 0;
    if (!S.next(0, cur)) return;
    f32x4 acc[2][2][4][2];
#pragma unroll
    for (int a = 0; a < 2; ++a)
#pragma unroll
        for (int b = 0; b < 2; ++b)
#pragma unroll
            for (int m = 0; m < 4; ++m)
#pragma unroll
                for (int n = 0; n < 2; ++n) acc[a][b][m][n] = (f32x4){0.f, 0.f, 0.f, 0.f};
    bf16x8 At[4][2], B0[2][2], B1[2][2];
    unsigned cA = PG8_UA(cur) + (unsigned)cur.kt0 * kstep, cB = PG8_UB(cur) + (unsigned)cur.kt0 * kstep;
    int nt = cur.nk < 0 ? nt_full : cur.nk;
    S.a_ready(cur);
    if constexpr (SP2) {
        PG8_STAGE(PG8_SB(0, 0), cB, voffB, rsB); PG8_STAGE(PG8_SB(0, 1), cB + hstepB, voffB, rsB); PG8_STAGE(PG8_SA(0, 0), cA, voffA, rsA); PG8_STAGE(PG8_SA(0, 1), cA + hstepA, voffA, rsA);
        if (wr == 1) PG8_BAR;
        PG8_WAIT_V(2); PG8_BAR;
        PG8_STAGE(PG8_SB(1, 0), cB + kstep, voffB, rsB); PG8_STAGE(PG8_SA(1, 0), cA + kstep, voffA, rsA); PG8_STAGE(PG8_SB(1, 1), cB + hstepB + kstep, voffB, rsB);
        PG8_WAIT_V(6); PG8_BAR;
    } else {
        PG8_STAGE(PG8_SB(0, 0), cB, voffB, rsB); PG8_STAGE(PG8_SA(0, 0), cA, voffA, rsA); PG8_STAGE(PG8_SB(0, 1), cB + hstepB, voffB, rsB); PG8_STAGE(PG8_SA(0, 1), cA + hstepA, voffA, rsA);
        if (wr == 1) PG8_BAR;
        PG8_WAIT_V(4); PG8_BAR;
        PG8_STAGE(PG8_SB(1, 0), cB + kstep, voffB, rsB); PG8_STAGE(PG8_SA(1, 0), cA + kstep, voffA, rsA); PG8_STAGE(PG8_SB(1, 1), cB + hstepB + kstep, voffB, rsB);
        PG8_WAIT_V(6); PG8_BAR;
    }
    for (;;) {
        const bool has_next = S.next(ui + 1, nxt);
        const unsigned nA = has_next ? PG8_UA(nxt) + (unsigned)nxt.kt0 * kstep : cA, nB = has_next ? PG8_UB(nxt) + (unsigned)nxt.kt0 * kstep : cB;
        for (int t = 0; t < nt; t += 2) {
            const bool last = (t == nt - 2);
            const unsigned a1 = cA + (unsigned)(t + 1) * kstep;
            const unsigned a2 = last ? nA : cA + (unsigned)(t + 2) * kstep, b2 = last ? nB : cB + (unsigned)(t + 2) * kstep;
            const unsigned a3 = a2 + kstep, b3 = b2 + kstep;
            if (last && has_next) S.a_ready(nxt);
            if constexpr (SP2) {
            PG8_LDB(B0, 0, 0); PG8_LDB(B1, 0, 1); PG8_SCHED; PG8_LDA(At, 0, 0); PG8_STAGE(PG8_SA(1, 1), a1 + hstepA, voffA, rsA);
            PG8_WAIT_V(8); PG8_WAIT_L(0); PG8_BAR; PG8_MMA(0, 0, At, B0); PG8_MMA(0, 1, At, B1); PG8_BAR; PG8_SCHED;
            PG8_LDA(At, 0, 1); PG8_STAGE(PG8_SB(0, 0), b2, voffB, rsB); PG8_STAGE(PG8_SB(0, 1), b2 + hstepB, voffB, rsB); PG8_STAGE(PG8_SA(0, 0), a2, voffA, rsA);
            PG8_WAIT_V(8); PG8_WAIT_L(0); PG8_BAR; PG8_MMA(1, 0, At, B0); PG8_MMA(1, 1, At, B1); PG8_BAR; PG8_SCHED;
            PG8_LDB(B0, 1, 0); PG8_LDB(B1, 1, 1); PG8_SCHED; PG8_LDA(At, 1, 0); PG8_STAGE(PG8_SA(0, 1), a2 + hstepA, voffA, rsA);
            PG8_WAIT_V(8); PG8_WAIT_L(0); PG8_BAR; PG8_MMA(0, 0, At, B0); PG8_MMA(0, 1, At, B1); PG8_BAR; PG8_SCHED;
            PG8_LDA(At, 1, 1); PG8_STAGE(PG8_SB(1, 0), b3, voffB, rsB); PG8_STAGE(PG8_SB(1, 1), b3 + hstepB, voffB, rsB); PG8_STAGE(PG8_SA(1, 0), a3, voffA, rsA);
            PG8_WAIT_V(8); PG8_WAIT_L(0); PG8_BAR; PG8_MMA(1, 0, At, B0); PG8_MMA(1, 1, At, B1); PG8_BAR; PG8_SCHED;
            } else {
            PG8_LDB(B0, 0, 0); PG8_SCHED; PG8_LDA(At, 0, 0); PG8_STAGE(PG8_SA(1, 1), a1 + hstepA, voffA, rsA);
            PG8_WAIT_L(8); PG8_BAR; PG8_WAIT_L(0); PG8_MMA(0, 0, At, B0); PG8_BAR; PG8_SCHED;
            PG8_LDB(B1, 0, 1); PG8_STAGE(PG8_SB(0, 0), b2, voffB, rsB);
            PG8_BAR; PG8_WAIT_L(0); PG8_MMA(0, 1, At, B1); PG8_BAR;
            PG8_LDA(At, 0, 1); PG8_STAGE(PG8_SA(0, 0), a2, voffA, rsA);
            PG8_BAR; PG8_WAIT_L(0); PG8_MMA(1, 0, At, B0); PG8_BAR; PG8_SCHED;
            PG8_STAGE(PG8_SB(0, 1), b2 + hstepB, voffB, rsB);
            PG8_WAIT_V(6); PG8_BAR; PG8_MMA(1, 1, At, B1); PG8_BAR;
            PG8_LDB(B0, 1, 0); PG8_SCHED; PG8_LDA(At, 1, 0); PG8_STAGE(PG8_SA(0, 1), a2 + hstepA, voffA, rsA);
            PG8_WAIT_L(8); PG8_BAR; PG8_WAIT_L(0); PG8_MMA(0, 0, At, B0); PG8_BAR; PG8_SCHED;
            PG8_LDB(B1, 1, 1); PG8_STAGE(PG8_SB(1, 0), b3, voffB, rsB);
            PG8_BAR; PG8_WAIT_L(0); PG8_MMA(0, 1, At, B1); PG8_BAR;
            PG8_LDA(At, 1, 1); PG8_STAGE(PG8_SA(1, 0), a3, voffA, rsA);
            PG8_BAR; PG8_WAIT_L(0); PG8_MMA(1, 0, At, B0); PG8_BAR; PG8_SCHED;
            PG8_STAGE(PG8_SB(1, 1), b3 + hstepB, voffB, rsB);
            PG8_WAIT_V(6); PG8_BAR; PG8_MMA(1, 1, At, B1); PG8_BAR;
            }
        }
        if constexpr (ALIGN_EPI) { if (wr == 0) PG8_BAR; }
        { const int l_e = lane_now(); const int fr_e = l_e & 15, fq_e = l_e >> 4;
          E(acc, cur, wr, wc, fr_e, fq_e); } S.done(cur);
        if (!has_next) break;
#pragma unroll
        for (int a = 0; a < 2; ++a)
#pragma unroll
            for (int b = 0; b < 2; ++b)
#pragma unroll
                for (int m = 0; m < 4; ++m)
#pragma unroll
                    for (int n = 0; n < 2; ++n) acc[a][b][m][n] = (f32x4){0.f, 0.f, 0.f, 0.f};
        cur = nxt; cA = nA; cB = nB; ++ui; nt = cur.nk < 0 ? nt_full : cur.nk;
        if constexpr (ALIGN_EPI) { if (wr == 1) PG8_BAR; }
    }
    PG8_WAIT_V(0);
    if constexpr (!ALIGN_EPI) { if (wr == 0) PG8_BAR; }
    PG8_BAR;
#undef PG8_UA
#undef PG8_UB
#undef PG8_SA
#undef PG8_SB
#undef PG8_STAGE
#undef PG8_LDA
#undef PG8_LDB
#undef PG8_MMA
#undef PG8_CAT
#undef PG8_WAIT_V
#undef PG8_WAIT_L
#undef PG8_BAR
#undef PG8_SCHED
}
}

#ifndef PG8_SP2
#define PG8_SP2 true
#endif
#ifndef PG8_ALIGN
#define PG8_ALIGN true
#endif

constexpr int NWAVES = 8;
constexpr int DM = 4096, DFF = 11008, PW = 2048, LW = 4096, INW = 10240, NGATE = 8192;
constexpr int NBP = 4, TP = 2064, NBS = 8, TS = 32, NMETA = 16, SEQ = 2048;
constexpr int MPROMPT = NBP * TP;
constexpr int MREAL = MPROMPT + NBS * TS;
constexpr int MPAD = 8704;
constexpr float ALPHA = 1.189207115002721f;
constexpr float LN_EPS = 1e-5f;
constexpr int NPHASE = 15;
constexpr size_t O_YP = 0, O_YS = 33554432, O_PP = 34603008, O_CP = 34725888, O_LP = 34775040, O_PS = 34791424, O_CS = 35037184, O_LS = 35135488, O_END = 35168256;

constexpr size_t MiB = 1u << 20;
constexpr size_t WS_CTL = 0, CTL_ZERO_BYTES = 1024 * 1024;
constexpr size_t WS_CMAX1 = 256 * 1024, WS_CMAX2 = 384 * 1024, WS_CMAXG = 512 * 1024;
constexpr size_t WS_CMAXZ = 896 * 1024;
constexpr size_t WS_RS0 = 640 * 1024, WS_RS1 = 704 * 1024, WS_RS2 = 768 * 1024;
constexpr size_t WS_WMIX = 1 * MiB, WS_WPOOL = 145 * MiB, WS_WLRU = 147 * MiB, WS_WUPP = 151 * MiB, WS_WUPL = 167 * MiB, WS_WOUT = 199 * MiB;
constexpr size_t WS_WFA = 231 * MiB, WS_WFB = 403 * MiB;
constexpr size_t WS_XB = 489 * MiB;
constexpr size_t WS_H = 557 * MiB;
constexpr size_t WS_A = WS_H, WS_D = WS_H + 136 * MiB;
constexpr size_t WS_V = 740 * MiB;
constexpr size_t WS_MP = WS_V;
constexpr size_t WS_X1F = 876 * MiB;
constexpr size_t WS_BX = 1012 * MiB, WS_X2F = WS_BX, WS_WZB = WS_BX;
constexpr size_t WS_Z = 1148 * MiB, WS_MB = WS_Z;
constexpr size_t WS_GATES = 1318 * MiB;
constexpr size_t WS_YA = 1454 * MiB, WS_YB = 1488 * MiB;
constexpr size_t WS_CV = 1556 * MiB;
constexpr size_t WS_END = 1557 * MiB;
static_assert(WS_D + (size_t)MPAD * PW * 2 <= WS_V && WS_H + (size_t)MPAD * DFF * 2 <= WS_V, "ws map");

constexpr int CW_TMO = 0, CW_CODE = 1;
constexpr int CW_BAR = 4096;

constexpr int RING_OFF = 0, RING_BYTES = 131072;
constexpr int LDSCTL_OFF = RING_BYTES, MISC_OFF = LDSCTL_OFF + 320;
constexpr int LDS_BYTES = 147456;

#define GAS __attribute__((address_space(1)))
#define LAS __attribute__((address_space(3)))
typedef unsigned short bf16;
typedef unsigned v4u __attribute__((ext_vector_type(4)));
typedef unsigned v2u __attribute__((ext_vector_type(2)));
typedef float f32x4 __attribute__((ext_vector_type(4)));
typedef int i32x4_t __attribute__((ext_vector_type(4)));
typedef GAS unsigned gu32;
#define RLX_AGENT __ATOMIC_RELAXED, __HIP_MEMORY_SCOPE_AGENT
#define LDS_WAIT() asm volatile("s_waitcnt lgkmcnt(0)" ::: "memory")
#define VM_WAIT() asm volatile("s_waitcnt vmcnt(0)" ::: "memory")
__device__ __forceinline__ unsigned f2bf(float f) { unsigned u = __builtin_bit_cast(unsigned, f); return (u + 0x7fffu + ((u >> 16) & 1u)) >> 16; }
__device__ __forceinline__ unsigned pk2(float lo, float hi) { return f2bf(lo) | (f2bf(hi) << 16); }
__device__ __forceinline__ float bflo(unsigned w) { return __builtin_bit_cast(float, w << 16); }
__device__ __forceinline__ float bfhi(unsigned w) { return __builtin_bit_cast(float, w & 0xffff0000u); }
#define PK8(a, b, old, hi) __builtin_amdgcn_cvt_pk_fp8_f32(__builtin_amdgcn_fmed3f((a), -448.f, 448.f), __builtin_amdgcn_fmed3f((b), -448.f, 448.f), (old), (hi))
__device__ __forceinline__ float sigm(float x) { return __builtin_amdgcn_rcpf(1.0f + __expf(-x)); }
__device__ __forceinline__ int q8i(float x) { return (int)__builtin_rintf(x); }
__device__ __forceinline__ unsigned pack4(int a, int b, int c, int d) { return (unsigned)(a & 255) | ((unsigned)(b & 255) << 8) | ((unsigned)(c & 255) << 16) | ((unsigned)d << 24); }
__device__ __forceinline__ float inv127(unsigned mbits) { const float m = __builtin_bit_cast(float, mbits); return m > 0.f ? 127.f / m : 0.f; }
__device__ __forceinline__ float gelu_tanh(float x) { const float t = 1.5957691216057308f * (x + 0.044715f * x * x * x); return x * sigm(t); }

#define XB_TMO      128
#define XB_XCNT(j)  (256  + 64 * (j))
#define XB_XSUB(j)  (1280 + 64 * (j))
#define XB_XGEN(j)  (2304 + 64 * (j))
#define XB_TOP      3328
#define XB_TOPGEN   3392
#define XCD_BAR_WORDS 3456
#define XB_SPIN_CAP (1u << 18)

__device__ __forceinline__ unsigned xb_ld(unsigned* p)              { return __hip_atomic_load(p, __ATOMIC_RELAXED, __HIP_MEMORY_SCOPE_AGENT); }
__device__ __forceinline__ unsigned xb_add(unsigned* p, unsigned v) { return __hip_atomic_fetch_add(p, v, __ATOMIC_RELAXED, __HIP_MEMORY_SCOPE_AGENT); }
__device__ __forceinline__ unsigned xb_xcc_id() { return (unsigned)__builtin_amdgcn_s_getreg((3 << 11) | 20) & 0xFu; }
#define XB_SPIN(cond, bar) do { unsigned _sp = 0; while (cond) { __builtin_amdgcn_s_sleep(1); \
    if ((++_sp & 255u) == 0u) { if (xb_ld(&(bar)[XB_TMO])) break; if (_sp > XB_SPIN_CAP) { atomicAdd(&(bar)[XB_TMO], 1u); break; } } } } while (0)

struct XcdBarrier {
    unsigned* bar; unsigned x;
    volatile LAS unsigned* st;
};
__device__ __forceinline__ XcdBarrier xcd_barrier_post(unsigned* bar, volatile LAS unsigned* st, bool t0  ) {
    XcdBarrier b; b.bar = bar; b.x = xb_xcc_id(); b.st = st;
    if (t0) (void)xb_add(&bar[XB_XCNT(b.x)], 1u);
    return b;
}
__device__ __forceinline__ void xcd_barrier_complete(unsigned* bar, unsigned x, unsigned& nloc, unsigned& nx) {
    const unsigned G = gridDim.x * gridDim.y * gridDim.z;
    unsigned sum, cnt, mine, sp = 0u;
    for (;;) {
        sum = 0u; cnt = 0u; mine = 0u;
#pragma unroll
        for (unsigned j = 0; j < 16; ++j) { const unsigned c = xb_ld(&bar[XB_XCNT(j)]); sum += c; cnt += (c > 0u) ? 1u : 0u; mine = (j == x) ? c : mine; }
        if (sum == G) break;
        __builtin_amdgcn_s_sleep(1);
        if ((++sp & 255u) == 0u) { if (xb_ld(&bar[XB_TMO])) break; if (sp > XB_SPIN_CAP) { atomicAdd(&bar[XB_TMO], 1u); break; } }
    }
    nloc = mine > 0u ? mine : 1u; nx = cnt > 0u ? cnt : 1u;
}
__device__ __forceinline__ void xcd_barrier(const XcdBarrier& b, bool t0  ) {
    asm volatile("s_waitcnt vmcnt(0)" ::: "memory");
    __syncthreads();
    if (t0) {
        unsigned* bar = b.bar;
        __builtin_amdgcn_s_waitcnt(0);
        unsigned nloc = b.st[0], nx = b.st[1];
        if (nloc == 0u) { xcd_barrier_complete(bar, b.x, nloc, nx); b.st[0] = nloc; b.st[1] = nx; }
        const unsigned old = xb_add(&bar[XB_XSUB(b.x)], 1u);
        const unsigned gen = old / nloc;
        if (old + 1u == (gen + 1u) * nloc) {
            __builtin_amdgcn_fence(__ATOMIC_RELEASE, "agent");
            asm volatile("s_waitcnt vmcnt(0)" ::: "memory");
            const unsigned og = xb_add(&bar[XB_TOP], 1u);
            const unsigned tg = og / nx;
            if (og + 1u == (tg + 1u) * nx) xb_add(&bar[XB_TOPGEN], 1u);
            else XB_SPIN(xb_ld(&bar[XB_TOPGEN]) == tg, bar);
            __builtin_amdgcn_fence(__ATOMIC_ACQUIRE, "agent");
            xb_add(&bar[XB_XGEN(b.x)], 1u);
            asm volatile("s_waitcnt vmcnt(0)" ::: "memory");
        } else {
            XB_SPIN(xb_ld(&bar[XB_XGEN(b.x)]) == gen, bar);
            __builtin_amdgcn_fence(__ATOMIC_ACQUIRE, "agent");
            asm volatile("s_waitcnt vmcnt(0)" ::: "memory");
        }
    }
    __syncthreads();
}

#define WDPP(x, ctrl) __builtin_bit_cast(float, __builtin_amdgcn_update_dpp(0, __builtin_bit_cast(int, (x)), (ctrl), 0xf, 0xf, false))
__device__ __forceinline__ float wave_sum(float v) {
    v += WDPP(v, 0xB1); v += WDPP(v, 0x4E); v += WDPP(v, 0x141); v += WDPP(v, 0x140);
    v += __shfl_xor(v, 16); v += __shfl_xor(v, 32);
    return v;
}
__device__ __forceinline__ float wave_max(float v) {
    v = fmaxf(v, WDPP(v, 0xB1)); v = fmaxf(v, WDPP(v, 0x4E)); v = fmaxf(v, WDPP(v, 0x141)); v = fmaxf(v, WDPP(v, 0x140));
    v = fmaxf(v, __shfl_xor(v, 16)); v = fmaxf(v, __shfl_xor(v, 32));
    return v;
}
__device__ __forceinline__ const float* x0_row(const float* xp, const float* xs, const float* meta, int row) {
    if (row < MPROMPT) { const int b = row / TP, t = row - b * TP; return t < NMETA ? meta + (size_t)t * DM : xp + ((size_t)b * SEQ + (t - NMETA)) * DM; }
    if (row < MREAL) return xs + (size_t)(row - MPROMPT) * DM;
    return nullptr;
}

__device__ __forceinline__ void tr_item(const float* W, int ldw, bf16* WT, int ldwt, int k0, int n0, int drow0, LAS unsigned* scr, int lane) {
    const int r = lane >> 4, c = lane & 15;
    const float* src = W + (size_t)(k0 + 2 * r) * ldw + n0 + 4 * c;
    f32x4 lo[8], hi[8];
#pragma unroll
    for (int j = 0; j < 8; ++j) { lo[j] = __builtin_nontemporal_load((const f32x4*)(src + (size_t)(8 * j) * ldw)); hi[j] = __builtin_nontemporal_load((const f32x4*)(src + (size_t)(8 * j + 1) * ldw)); }
#pragma unroll
    for (int j = 0; j < 8; ++j)
#pragma unroll
        for (int e = 0; e < 4; ++e) scr[(4 * c + e) * 32 + ((j ^ (c & 7)) * 4) + r] = pg8::cvt_pk_bf16(lo[j][e], hi[j][e]);
    LDS_WAIT(); asm volatile("" ::: "memory");
    const int q = lane & 7;
#pragma unroll
    for (int i = 0; i < 8; ++i) { const int n = (lane >> 3) + 8 * i; const v4u o = *(const LAS v4u*)(scr + n * 32 + ((q ^ ((n >> 2) & 7)) * 4));
        *(GAS v4u*)(WT + (size_t)(drow0 + n) * ldwt + k0 + 8 * q) = o; }
    LDS_WAIT(); asm volatile("" ::: "memory");
}
__device__ __forceinline__ void tr_item8(const float* W, int ldw, unsigned char* WT, int pitchB, int k0, int n0, int drow0, LAS unsigned* scr, int lane, float sc) {
    const int r = lane >> 4, c = lane & 15;
    const float* src = W + (size_t)(k0 + 4 * r) * ldw + n0 + 4 * c;
    f32x4 v[8][4];
#pragma unroll
    for (int j = 0; j < 8; ++j)
#pragma unroll
        for (int i = 0; i < 4; ++i) v[j][i] = __builtin_nontemporal_load((const f32x4*)(src + (size_t)(16 * j + i) * ldw));
#pragma unroll
    for (int j = 0; j < 8; ++j)
#pragma unroll
        for (int e = 0; e < 4; ++e) { int w = PK8(v[j][0][e] * sc, v[j][1][e] * sc, 0, false); w = PK8(v[j][2][e] * sc, v[j][3][e] * sc, w, true);
            scr[(4 * c + e) * 32 + ((j ^ (c & 7)) * 4) + r] = (unsigned)w; }
    LDS_WAIT(); asm volatile("" ::: "memory");
    const int q = lane & 7;
#pragma unroll
    for (int i = 0; i < 8; ++i) { const int n = (lane >> 3) + 8 * i; const v4u o = *(const LAS v4u*)(scr + n * 32 + ((q ^ ((n >> 2) & 7)) * 4));
        *(GAS v4u*)(WT + (size_t)(drow0 + n) * pitchB + k0 + 16 * q) = o; }
    LDS_WAIT(); asm volatile("" ::: "memory");
}
__device__ __forceinline__ void tr_job(const float* W, int K, int N, bf16* WT, int mode, int roff, int it, LAS unsigned* scr, int lane) {
    const int nblk = N / 64, kb = it / nblk, nb = it - kb * nblk, k0 = 64 * kb, n0 = 64 * nb;
    int drow0;
    if (mode == 0) drow0 = roff + n0;
    else if (mode == 1) { const int half = N >> 1; const bool up = n0 >= half; const int nn = up ? n0 - half : n0; drow0 = (nn >> 7) * 256 + (nn & 127) + (up ? 128 : 0); }
    else drow0 = roff + (n0 >> 7) * 256 + (n0 & 127);
    tr_item(W, N, WT, K, k0, n0, drow0, scr, lane);
}


__device__ __forceinline__ void tr_item_i8(const float* W, int ldw, unsigned char* WT, int pitchB, int k0, int n0, int drow0, LAS unsigned* scr, int lane, const unsigned* cmax) {
    const int r = lane >> 4, c = lane & 15;
    const float* src = W + (size_t)(k0 + 4 * r) * ldw + n0 + 4 * c;
    f32x4 v[8][4];
#pragma unroll
    for (int j = 0; j < 8; ++j)
#pragma unroll
        for (int i = 0; i < 4; ++i) v[j][i] = __builtin_nontemporal_load((const f32x4*)(src + (size_t)(16 * j + i) * ldw));
    const v4u cm = *(const v4u*)(cmax + n0 + 4 * c);
    const float inv[4] = {inv127(cm.x), inv127(cm.y), inv127(cm.z), inv127(cm.w)};
#pragma unroll
    for (int j = 0; j < 8; ++j)
#pragma unroll
        for (int e = 0; e < 4; ++e) scr[(4 * c + e) * 32 + ((j ^ (c & 7)) * 4) + r] = pack4(q8i(v[j][0][e] * inv[e]), q8i(v[j][1][e] * inv[e]), q8i(v[j][2][e] * inv[e]), q8i(v[j][3][e] * inv[e]));
    LDS_WAIT(); asm volatile("" ::: "memory");
    const int q = lane & 7;
#pragma unroll
    for (int i = 0; i < 8; ++i) { const int n = (lane >> 3) + 8 * i; const v4u o = *(const LAS v4u*)(scr + n * 32 + ((q ^ ((n >> 2) & 7)) * 4));
        *(GAS v4u*)(WT + (size_t)(drow0 + n) * pitchB + k0 + 16 * q) = o; }
    LDS_WAIT(); asm volatile("" ::: "memory");
}
__device__ __forceinline__ void tr_job_i8(const float* W, int K, int N, unsigned char* WT, int mode, int it, LAS unsigned* scr, int lane, const unsigned* cmax) {
    const int nblk = N / 64, kb = it / nblk, nb = it - kb * nblk, k0 = 128 * kb, n0 = 64 * nb;
    int drow0 = n0;
    if (mode == 1) { const int half = N >> 1; const bool up = n0 >= half; const int nn = up ? n0 - half : n0; drow0 = (nn >> 7) * 256 + (nn & 127) + (up ? 128 : 0); }
    tr_item_i8(W, N, WT, K, k0, n0, drow0, scr, lane, cmax);
}
template <bool NT> __device__ __forceinline__ void colmax_job(const float* W, int N, unsigned* cmax, int it, int lane) {
    const int nblk = N / 256, kc = it / nblk, nb = it - kc * nblk;
    const float* src = W + (size_t)(64 * kc) * N + 256 * nb + 4 * lane;
    f32x4 m = (f32x4){0.f, 0.f, 0.f, 0.f};
#pragma unroll 1
    for (int jj = 0; jj < 64; jj += 16) { f32x4 v[16];
#pragma unroll
        for (int i = 0; i < 16; ++i) v[i] = NT ? __builtin_nontemporal_load((const f32x4*)(src + (size_t)(jj + i) * N)) : *(const f32x4*)(src + (size_t)(jj + i) * N);
#pragma unroll
        for (int i = 0; i < 16; ++i) { m.x = fmaxf(m.x, fabsf(v[i].x)); m.y = fmaxf(m.y, fabsf(v[i].y)); m.z = fmaxf(m.z, fabsf(v[i].z)); m.w = fmaxf(m.w, fabsf(v[i].w)); } }
    unsigned* p = cmax + 256 * nb + 4 * lane;
    const v4u mb = __builtin_bit_cast(v4u, m);
    (void)__hip_atomic_fetch_max(p + 0, mb.x, RLX_AGENT); (void)__hip_atomic_fetch_max(p + 1, mb.y, RLX_AGENT);
    (void)__hip_atomic_fetch_max(p + 2, mb.z, RLX_AGENT); (void)__hip_atomic_fetch_max(p + 3, mb.w, RLX_AGENT);
}

template <int NB> __device__ __forceinline__ void scan_blk1(const unsigned* ap, float& h, float& S) {
    unsigned wv[NB];
#pragma unroll
    for (int i = 0; i < NB; ++i) wv[i] = ap[(size_t)i * LW];
#pragma unroll
    for (int i = 0; i < NB; ++i) { const float la = bflo(wv[i]); h = __expf(la) * h + bfhi(wv[i]); S += la; }
}
template <int NB> __device__ __forceinline__ void scan_blk3(const unsigned* ap, const bf16* gp, bf16* yp, float& h) {
    unsigned wv[NB], gv[NB];
#pragma unroll
    for (int i = 0; i < NB; ++i) { wv[i] = ap[(size_t)i * LW]; gv[i] = gp[(size_t)i * INW]; }
#pragma unroll
    for (int i = 0; i < NB; ++i) { h = __expf(bflo(wv[i])) * h + bfhi(wv[i]); yp[(size_t)i * LW] = (bf16)f2bf(h * __builtin_bit_cast(float, gv[i] << 16)); }
}
using pg8::Unit; using pg8::BM; using pg8::HALF; using pg8::cvt_pk_bf16;
template <bool F8OUT  > struct EpiSwiglu {
    static constexpr bool PERM = true; bf16* H;
    __device__ __forceinline__ void operator()(const f32x4 (&acc)[2][2][4][2], const Unit& u, int wr, int wc, int fr, int fq) const {
        const int row0 = u.pm * BM + wr * 64 + fr, col0 = u.pn * 128 + wc * 32 + 8 * fq;
#pragma unroll
        for (int ai = 0; ai < 2; ++ai)
#pragma unroll
            for (int m = 0; m < 4; ++m) { const size_t eo = (size_t)(row0 + ai * HALF + m * 16) * DFF + col0;
                float h[8];
#pragma unroll
                for (int n = 0; n < 2; ++n)
#pragma unroll
                    for (int j = 0; j < 4; ++j) { const float g = acc[ai][0][m][n][j], up = acc[ai][1][m][n][j]; h[4 * n + j] = g * up * sigm(g); }
                if constexpr (F8OUT) {
                    int q0 = PK8(h[0] * 4.f, h[1] * 4.f, 0, false); q0 = PK8(h[2] * 4.f, h[3] * 4.f, q0, true);
                    int q1 = PK8(h[4] * 4.f, h[5] * 4.f, 0, false); q1 = PK8(h[6] * 4.f, h[7] * 4.f, q1, true);
                    v2u qq; qq.x = (unsigned)q0; qq.y = (unsigned)q1; *(v2u*)((unsigned char*)H + eo) = qq;
                } else {
                    v4u w; w.x = cvt_pk_bf16(h[0], h[1]); w.y = cvt_pk_bf16(h[2], h[3]); w.z = cvt_pk_bf16(h[4], h[5]); w.w = cvt_pk_bf16(h[6], h[7]);
                    *(v4u*)(H + eo) = w; } }
    }
};
struct EpiSwigluI8 {
    static constexpr bool PERM = true; unsigned char* H; const float* rs; const unsigned* cmax;
    __device__ __forceinline__ void operator()(const f32x4 (&acc)[2][2][4][2], const Unit& u, int wr, int wc, int fr, int fq) const {
        const int row0 = u.pm * BM + wr * 64 + fr, col0 = u.pn * 128 + wc * 32 + 8 * fq;
        float cg[8], cu[8];
        { const v4u a0 = *(const v4u*)(cmax + col0), a1 = *(const v4u*)(cmax + col0 + 4), b0 = *(const v4u*)(cmax + DFF + col0), b1 = *(const v4u*)(cmax + DFF + col0 + 4);
          const unsigned ga[8] = {a0.x, a0.y, a0.z, a0.w, a1.x, a1.y, a1.z, a1.w}, ua[8] = {b0.x, b0.y, b0.z, b0.w, b1.x, b1.y, b1.z, b1.w};
#pragma unroll
          for (int i = 0; i < 8; ++i) { cg[i] = __builtin_bit_cast(float, ga[i]) * (1.f / 127.f); cu[i] = __builtin_bit_cast(float, ua[i]) * (4.f / 127.f); } }
        float rsv[8];
#pragma unroll
        for (int q = 0; q < 8; ++q) rsv[q] = rs[row0 + (q >> 2) * HALF + (q & 3) * 16];
#pragma unroll
        for (int ai = 0; ai < 2; ++ai)
#pragma unroll
            for (int m = 0; m < 4; ++m) { const int row = row0 + ai * HALF + m * 16; const size_t eo = (size_t)row * DFF + col0;
                const float r = rsv[ai * 4 + m];
                float h[8];
#pragma unroll
                for (int n = 0; n < 2; ++n) { const f32x4 gv = __builtin_convertvector(__builtin_bit_cast(i32x4_t, acc[ai][0][m][n]), f32x4), uv = __builtin_convertvector(__builtin_bit_cast(i32x4_t, acc[ai][1][m][n]), f32x4);
#pragma unroll
                    for (int j = 0; j < 4; ++j) { const float g = gv[j] * (r * cg[4 * n + j]), up = uv[j] * (r * cu[4 * n + j]);
                        h[4 * n + j] = g * up * sigm(g); } }
                int q0 = PK8(h[0], h[1], 0, false); q0 = PK8(h[2], h[3], q0, true);
                int q1 = PK8(h[4], h[5], 0, false); q1 = PK8(h[6], h[7], q1, true);
                v2u qq; qq.x = (unsigned)q0; qq.y = (unsigned)q1; *(v2u*)(H + eo) = qq;
                __builtin_amdgcn_sched_barrier(0); }
    }
};
template <int MODE  > struct EpiResid {
    static constexpr bool PERM = true; bf16* V; const bf16* R; const float* xp; const float* xs; const float* meta; float scale; float* slab;
    __device__ __forceinline__ void operator()(const f32x4 (&acc)[2][2][4][2], const Unit& u, int wr, int wc, int fr, int fq) const {
        if (u.slab >= 0) {
            float* sp = slab + (size_t)u.slab * 65536 + (size_t)(wr * 64 + fr) * 256 + wc * 32 + 8 * fq;
#pragma unroll
            for (int ai = 0; ai < 2; ++ai)
#pragma unroll
                for (int m = 0; m < 4; ++m)
#pragma unroll
                    for (int bj = 0; bj < 2; ++bj) { float* q = sp + (ai * HALF + m * 16) * 256 + bj * HALF; *(f32x4*)q = acc[ai][bj][m][0]; *(f32x4*)(q + 4) = acc[ai][bj][m][1]; }
            return;
        }
        const int row0 = u.pm * BM + wr * 64 + fr, col0 = u.pn * BM + wc * 32 + 8 * fq;
#pragma unroll
        for (int ai = 0; ai < 2; ++ai) {
            v4u rw[4][2]; f32x4 rf[4][2][2]; float mk[4];
#pragma unroll
            for (int m = 0; m < 4; ++m) { const int row = row0 + ai * HALF + m * 16; mk[m] = ALPHA;
                if (MODE == 1) {
#pragma unroll
                    for (int bj = 0; bj < 2; ++bj) rw[m][bj] = *(const v4u*)(R + (size_t)row * DM + col0 + bj * HALF);
                } else { const float* rp = x0_row(xp, xs, meta, row); const float* rq = rp ? rp : xp;
                    mk[m] = rp ? ALPHA : 0.f;
#pragma unroll
                    for (int bj = 0; bj < 2; ++bj) { rf[m][bj][0] = *(const f32x4*)(rq + col0 + bj * HALF); rf[m][bj][1] = *(const f32x4*)(rq + col0 + bj * HALF + 4); } } }
            __builtin_amdgcn_sched_barrier(0);
#pragma unroll
            for (int m = 0; m < 4; ++m) { const int row = row0 + ai * HALF + m * 16;
#pragma unroll
                for (int bj = 0; bj < 2; ++bj) { const size_t o = (size_t)row * DM + col0 + bj * HALF;
                    f32x4 r0, r1;
                    if (MODE == 1) { const v4u w = rw[m][bj]; r0 = (f32x4){bflo(w.x), bfhi(w.x), bflo(w.y), bfhi(w.y)}; r1 = (f32x4){bflo(w.z), bfhi(w.z), bflo(w.w), bfhi(w.w)}; }
                    else { r0 = rf[m][bj][0]; r1 = rf[m][bj][1]; }
                    const f32x4 v0 = r0 * mk[m] + acc[ai][bj][m][0] * scale, v1 = r1 * mk[m] + acc[ai][bj][m][1] * scale;
                    v4u w; w.x = cvt_pk_bf16(v0[0], v0[1]); w.y = cvt_pk_bf16(v0[2], v0[3]); w.z = cvt_pk_bf16(v1[0], v1[1]); w.w = cvt_pk_bf16(v1[2], v1[3]);
                    *(v4u*)(V + o) = w; } }
            __builtin_amdgcn_sched_barrier(0); }
    }
};
template <bool I8> struct EpiZ {
    static constexpr bool PERM = true; bf16* Z; const float* rs; const unsigned* cmax;
    __device__ __forceinline__ void operator()(const f32x4 (&acc)[2][2][4][2], const Unit& u, int wr, int wc, int fr, int fq) const {
        const int row0 = u.pm * BM + wr * 64 + fr, col0 = u.pn * BM + wc * 32 + 8 * fq; const bool gl = u.pn >= 24;
        float rsv[8]; f32x4 cs[2][2];
        if constexpr (I8) {
#pragma unroll
            for (int q = 0; q < 8; ++q) rsv[q] = rs[row0 + (q >> 2) * HALF + (q & 3) * 16] * (1.f / 127.f);
#pragma unroll
            for (int bj = 0; bj < 2; ++bj) { cs[bj][0] = __builtin_bit_cast(f32x4, *(const v4u*)(cmax + col0 + bj * HALF)); cs[bj][1] = __builtin_bit_cast(f32x4, *(const v4u*)(cmax + col0 + bj * HALF + 4)); } }
#pragma unroll
        for (int ai = 0; ai < 2; ++ai)
#pragma unroll
            for (int m = 0; m < 4; ++m) { bf16* rowp = Z + (size_t)(row0 + ai * HALF + m * 16) * INW + col0;
#pragma unroll
                for (int bj = 0; bj < 2; ++bj) { f32x4 v0 = acc[ai][bj][m][0], v1 = acc[ai][bj][m][1];
                    if constexpr (I8) { const float r = rsv[ai * 4 + m];
                        v0 = __builtin_convertvector(__builtin_bit_cast(i32x4_t, acc[ai][bj][m][0]), f32x4) * (cs[bj][0] * r); v1 = __builtin_convertvector(__builtin_bit_cast(i32x4_t, acc[ai][bj][m][1]), f32x4) * (cs[bj][1] * r); }
                    if (gl) {
#pragma unroll
                        for (int j = 0; j < 4; ++j) { v0[j] = gelu_tanh(v0[j]); v1[j] = gelu_tanh(v1[j]); } }
                    v4u w; w.x = cvt_pk_bf16(v0[0], v0[1]); w.y = cvt_pk_bf16(v0[2], v0[3]); w.z = cvt_pk_bf16(v1[0], v1[1]); w.w = cvt_pk_bf16(v1[2], v1[3]);
                    *(v4u*)(rowp + bj * HALF) = w; } }
    }
};
struct EpiGate {
    static constexpr bool PERM = true; bf16* Gt; const float* bg; const float* rs; const unsigned* cmax;
    __device__ __forceinline__ void operator()(const f32x4 (&acc)[2][2][4][2], const Unit& u, int wr, int wc, int fr, int fq) const {
        const int row0 = u.pm * BM + wr * 64 + fr, col0 = u.pn * BM + wc * 32 + 8 * fq;
        float rsv[8]; f32x4 cs[2][2], bs[2][2];
#pragma unroll
        for (int q = 0; q < 8; ++q) rsv[q] = rs[row0 + (q >> 2) * HALF + (q & 3) * 16];
#pragma unroll
        for (int bj = 0; bj < 2; ++bj) { cs[bj][0] = __builtin_bit_cast(f32x4, *(const v4u*)(cmax + col0 + bj * HALF)); cs[bj][1] = __builtin_bit_cast(f32x4, *(const v4u*)(cmax + col0 + bj * HALF + 4));
            bs[bj][0] = *(const f32x4*)(bg + col0 + bj * HALF); bs[bj][1] = *(const f32x4*)(bg + col0 + bj * HALF + 4); }
        __builtin_amdgcn_sched_barrier(0);
#pragma unroll
        for (int bj = 0; bj < 2; ++bj) { cs[bj][0] = cs[bj][0] * (1.f / 127.f); cs[bj][1] = cs[bj][1] * (1.f / 127.f); }
#pragma unroll
        for (int ai = 0; ai < 2; ++ai)
#pragma unroll
            for (int m = 0; m < 4; ++m) { bf16* rowp = Gt + (size_t)(row0 + ai * HALF + m * 16) * NGATE + col0; const float r = rsv[ai * 4 + m];
#pragma unroll
                for (int bj = 0; bj < 2; ++bj) {
                    const i32x4_t i0 = __builtin_bit_cast(i32x4_t, acc[ai][bj][m][0]), i1 = __builtin_bit_cast(i32x4_t, acc[ai][bj][m][1]);
                    f32x4 v0 = __builtin_convertvector(i0, f32x4) * (cs[bj][0] * r) + bs[bj][0], v1 = __builtin_convertvector(i1, f32x4) * (cs[bj][1] * r) + bs[bj][1];
#pragma unroll
                    for (int j = 0; j < 4; ++j) { v0[j] = sigm(v0[j]); v1[j] = sigm(v1[j]); }
                    v4u w; w.x = cvt_pk_bf16(v0[0], v0[1]); w.y = cvt_pk_bf16(v0[2], v0[3]); w.z = cvt_pk_bf16(v1[0], v1[1]); w.w = cvt_pk_bf16(v1[2], v1[3]);
                    *(v4u*)(rowp + bj * HALF) = w; }
                __builtin_amdgcn_sched_barrier(0); }
    }
};
struct EpiPool {
    static constexpr bool PERM = true; bf16* YA; const float* ps;
    __device__ __forceinline__ void operator()(const f32x4 (&acc)[2][2][4][2], const Unit& u, int wr, int wc, int fr, int fq) const {
        const int row0 = u.pm * BM + wr * 64 + fr, col0 = u.pn * BM + wc * 32 + 8 * fq;
        f32x4 sv[2][2];
#pragma unroll
        for (int bj = 0; bj < 2; ++bj)
#pragma unroll
            for (int n = 0; n < 2; ++n) sv[bj][n] = *(const f32x4*)(ps + col0 + bj * HALF + 4 * n);
#pragma unroll
        for (int ai = 0; ai < 2; ++ai)
#pragma unroll
            for (int m = 0; m < 4; ++m) { bf16* rowp = YA + (size_t)(row0 + ai * HALF + m * 16) * PW + col0;
#pragma unroll
                for (int bj = 0; bj < 2; ++bj) { const f32x4 v0 = acc[ai][bj][m][0] * sv[bj][0], v1 = acc[ai][bj][m][1] * sv[bj][1];
                    v4u w; w.x = cvt_pk_bf16(v0[0], v0[1]); w.y = cvt_pk_bf16(v0[2], v0[3]); w.z = cvt_pk_bf16(v1[0], v1[1]); w.w = cvt_pk_bf16(v1[2], v1[3]);
                    *(v4u*)(rowp + bj * HALF) = w; } }
    }
};
struct EpiLru {
    static constexpr bool PERM = true; unsigned* AB; const bf16* XC; const float* ba; const float* bxb; const float* cvp;
    __device__ __forceinline__ void operator()(const f32x4 (&acc)[2][2][4][2], const Unit& u, int wr, int wc, int fr, int fq) const {
        const int row0 = u.pm * BM + wr * 64 + fr, ch0 = u.pn * 128 + wc * 32 + 8 * fq;
        f32x4 bav[2], bxv[2], cv[2];
#pragma unroll
        for (int n = 0; n < 2; ++n) { bav[n] = *(const f32x4*)(ba + ch0 + 4 * n); bxv[n] = *(const f32x4*)(bxb + ch0 + 4 * n); cv[n] = *(const f32x4*)(cvp + ch0 + 4 * n); }
        v4u xwv[8];
#pragma unroll
        for (int q = 0; q < 8; ++q) xwv[q] = *(const v4u*)(XC + (size_t)(row0 + (q >> 2) * HALF + (q & 3) * 16) * LW + ch0);
        __builtin_amdgcn_sched_barrier(0);
#pragma unroll
        for (int ai = 0; ai < 2; ++ai)
#pragma unroll
            for (int m = 0; m < 4; ++m) { const size_t ro = (size_t)(row0 + ai * HALF + m * 16) * LW + ch0;
                const v4u xw = xwv[ai * 4 + m];
#pragma unroll
                for (int n = 0; n < 2; ++n) { const unsigned w0 = n ? xw.z : xw.x, w1 = n ? xw.w : xw.y;
                    const f32x4 xv = (f32x4){bflo(w0), bfhi(w0), bflo(w1), bfhi(w1)};
                    v4u pw;
#pragma unroll
                    for (int j = 0; j < 4; ++j) { const float r = sigm(acc[ai][0][m][n][j] + bav[n][j]), ig = sigm(acc[ai][1][m][n][j] + bxv[n][j]);
                        const float la = cv[n][j] * r, a = __expf(la), om = 1.0f - a * a;
                        pw[j] = cvt_pk_bf16(la, sqrtf(fmaxf(om, 0.0f)) * (ig * xv[j])); }
                    *(v4u*)(AB + ro + 4 * n) = pw; }
                __builtin_amdgcn_sched_barrier(0); }
    }
};
struct EpiUpPool {
    static constexpr bool PERM = true; bf16* MP; const bf16* Gt; float* slab;
    __device__ __forceinline__ void operator()(const f32x4 (&acc)[2][2][4][2], const Unit& u, int wr, int wc, int fr, int fq) const {
        const int row0 = u.pm * BM + wr * 64 + fr, col0 = u.pn * BM + wc * 32 + 8 * fq;
        float* sp = slab + (size_t)(u.slab >= 0 ? u.slab : 0) * 65536 + (size_t)(wr * 64 + fr) * 256 + wc * 32 + 8 * fq;
#pragma unroll
        for (int ai = 0; ai < 2; ++ai) {
            v4u gwv[4][2];
#pragma unroll
            for (int m = 0; m < 4; ++m)
#pragma unroll
                for (int bj = 0; bj < 2; ++bj) gwv[m][bj] = *(const v4u*)(Gt + (size_t)(row0 + ai * HALF + m * 16) * NGATE + col0 + bj * HALF);
            __builtin_amdgcn_sched_barrier(0);
#pragma unroll
            for (int m = 0; m < 4; ++m) { const int row = row0 + ai * HALF + m * 16;
#pragma unroll
                for (int bj = 0; bj < 2; ++bj) { const v4u gw = gwv[m][bj];
                    const f32x4 g0 = (f32x4){bflo(gw.x), bfhi(gw.x), bflo(gw.y), bfhi(gw.y)}, g1 = (f32x4){bflo(gw.z), bfhi(gw.z), bflo(gw.w), bfhi(gw.w)};
                    const f32x4 v0 = acc[ai][bj][m][0] * g0, v1 = acc[ai][bj][m][1] * g1;
                    if (u.slab >= 0) {
                        float* q = sp + (ai * HALF + m * 16) * 256 + bj * HALF; *(f32x4*)q = v0; *(f32x4*)(q + 4) = v1;
                    } else { v4u w; w.x = cvt_pk_bf16(v0[0], v0[1]); w.y = cvt_pk_bf16(v0[2], v0[3]); w.z = cvt_pk_bf16(v1[0], v1[1]); w.w = cvt_pk_bf16(v1[2], v1[3]);
                        *(v4u*)(MP + (size_t)row * DM + col0 + bj * HALF) = w; } } }
            __builtin_amdgcn_sched_barrier(0); }
    }
};
struct EpiUpLru {
    static constexpr bool PERM = true; bf16* Mb; const bf16* MP; const bf16* Gt; float* slab; const float* slab8;
    __device__ __forceinline__ void operator()(const f32x4 (&acc)[2][2][4][2], const Unit& u, int wr, int wc, int fr, int fq) const {
        const int row0 = u.pm * BM + wr * 64 + fr, col0 = u.pn * BM + wc * 32 + 8 * fq;
        if (u.slab >= 0) {
            float* sp = slab + (size_t)u.slab * 65536 + (size_t)(wr * 64 + fr) * 256 + wc * 32 + 8 * fq;
#pragma unroll
            for (int h = 0; h < 4; ++h) {
                v4u gwv[2][2]; f32x4 pv[2][2][2];
#pragma unroll
                for (int mm = 0; mm < 2; ++mm) { const int ai = h >> 1, m = 2 * (h & 1) + mm, row = row0 + ai * HALF + m * 16;
#pragma unroll
                    for (int bj = 0; bj < 2; ++bj) { gwv[mm][bj] = *(const v4u*)(Gt + (size_t)row * NGATE + DM + col0 + bj * HALF);
                        const float* q8p = slab8 + (size_t)u.slab * 65536 + (size_t)(wr * 64 + fr) * 256 + wc * 32 + 8 * fq + (ai * HALF + m * 16) * 256 + bj * HALF;
                        pv[mm][bj][0] = __builtin_nontemporal_load((const f32x4*)q8p); pv[mm][bj][1] = __builtin_nontemporal_load((const f32x4*)(q8p + 4)); } }
                __builtin_amdgcn_sched_barrier(0);
#pragma unroll
                for (int mm = 0; mm < 2; ++mm) { const int ai = h >> 1, m = 2 * (h & 1) + mm;
#pragma unroll
                    for (int bj = 0; bj < 2; ++bj) { const v4u gw = gwv[mm][bj];
                        const f32x4 g0 = (f32x4){bflo(gw.x), bfhi(gw.x), bflo(gw.y), bfhi(gw.y)}, g1 = (f32x4){bflo(gw.z), bfhi(gw.z), bflo(gw.w), bfhi(gw.w)};
                        float* q = sp + (ai * HALF + m * 16) * 256 + bj * HALF;
                        *(f32x4*)q = pv[mm][bj][0] + acc[ai][bj][m][0] * g0; *(f32x4*)(q + 4) = pv[mm][bj][1] + acc[ai][bj][m][1] * g1; } }
                __builtin_amdgcn_sched_barrier(0); }
            return;
        }
#pragma unroll
        for (int ai = 0; ai < 2; ++ai) {
            v4u gwv[4][2], mwv[4][2];
#pragma unroll
            for (int m = 0; m < 4; ++m) { const int row = row0 + ai * HALF + m * 16;
#pragma unroll
                for (int bj = 0; bj < 2; ++bj) { gwv[m][bj] = *(const v4u*)(Gt + (size_t)row * NGATE + DM + col0 + bj * HALF);
                    mwv[m][bj] = __builtin_nontemporal_load((const v4u*)(MP + (size_t)row * DM + col0 + bj * HALF)); } }
            __builtin_amdgcn_sched_barrier(0);
#pragma unroll
            for (int m = 0; m < 4; ++m) { const int row = row0 + ai * HALF + m * 16;
#pragma unroll
                for (int bj = 0; bj < 2; ++bj) { const v4u gw = gwv[m][bj], mw = mwv[m][bj];
                    const f32x4 g0 = (f32x4){bflo(gw.x), bfhi(gw.x), bflo(gw.y), bfhi(gw.y)}, g1 = (f32x4){bflo(gw.z), bfhi(gw.z), bflo(gw.w), bfhi(gw.w)};
                    const f32x4 v0 = (f32x4){bflo(mw.x), bfhi(mw.x), bflo(mw.y), bfhi(mw.y)} + acc[ai][bj][m][0] * g0, v1 = (f32x4){bflo(mw.z), bfhi(mw.z), bflo(mw.w), bfhi(mw.w)} + acc[ai][bj][m][1] * g1;
                    v4u w; w.x = cvt_pk_bf16(v0[0], v0[1]); w.y = cvt_pk_bf16(v0[2], v0[3]); w.z = cvt_pk_bf16(v1[0], v1[1]); w.w = cvt_pk_bf16(v1[2], v1[3]);
                    *(v4u*)(Mb + (size_t)row * DM + col0 + bj * HALF) = w; } }
            __builtin_amdgcn_sched_barrier(0); }
    }
};

template <int MODE, bool QC = false> __device__ __forceinline__ void ln_finish(f32x4 (&v)[16], const LAS f32x4* gb  , float* dst, bf16* xbrow, unsigned char* q8row, float* rsrow, int lane) {
    float s = 0.f;
#pragma unroll
    for (int j = 0; j < 16; ++j) s += (v[j].x + v[j].y) + (v[j].z + v[j].w);
    const float mean = wave_sum(s) * (1.f / DM); float s2 = 0.f;
#pragma unroll
    for (int j = 0; j < 16; ++j) { v[j] = v[j] - mean; s2 += (v[j].x * v[j].x + v[j].y * v[j].y) + (v[j].z * v[j].z + v[j].w * v[j].w); }
    const float rstd = 1.f / sqrtf(wave_sum(s2) * (1.f / DM) + LN_EPS);
    float mx = 0.f;
#pragma unroll
    for (int c = 0; c < 8; ++c) { const int o = 8 * lane + 512 * c;
        const f32x4 y0 = v[2 * c] * rstd * gb[(4 * c + 0) * 64 + lane] + gb[(4 * c + 2) * 64 + lane], y1 = v[2 * c + 1] * rstd * gb[(4 * c + 1) * 64 + lane] + gb[(4 * c + 3) * 64 + lane];
        if (MODE == 1) { *(f32x4*)(dst + o) = y0; *(f32x4*)(dst + o + 4) = y1; }
        if (MODE == 0) { v4u w; w.x = pg8::cvt_pk_bf16(y0.x, y0.y); w.y = pg8::cvt_pk_bf16(y0.z, y0.w); w.z = pg8::cvt_pk_bf16(y1.x, y1.y); w.w = pg8::cvt_pk_bf16(y1.z, y1.w); *(v4u*)(xbrow + o) = w;
            if (QC) { v[2 * c] = y0; v[2 * c + 1] = y1;
                mx = fmaxf(mx, fmaxf(fmaxf(fmaxf(fabsf(y0.x), fabsf(y0.y)), fmaxf(fabsf(y0.z), fabsf(y0.w))), fmaxf(fmaxf(fabsf(y1.x), fabsf(y1.y)), fmaxf(fabsf(y1.z), fabsf(y1.w))))); } } }
    if (MODE == 0 && QC) {
        mx = wave_max(mx); const float inv = mx > 0.f ? 127.f / mx : 0.f;
        if (lane == 0) *rsrow = mx * (1.f / 127.f);
#pragma unroll
        for (int c = 0; c < 8; ++c) { const f32x4 a = v[2 * c] * inv, b = v[2 * c + 1] * inv;
            v2u qq; qq.x = pack4(q8i(a.x), q8i(a.y), q8i(a.z), q8i(a.w)); qq.y = pack4(q8i(b.x), q8i(b.y), q8i(b.z), q8i(b.w)); *(v2u*)(q8row + 8 * lane + 512 * c) = qq; }
    }
}
template <int MODE> __device__ __forceinline__ float* ln_dst(int row, float* Xf, float* out) {
    if (MODE == 1) {
        if (row < MPROMPT) { const int b = row / TP, t = row - b * TP; if (t < NMETA) return nullptr; return out + O_YP + ((size_t)b * SEQ + (t - NMETA)) * DM; }
        return out + O_YS + (size_t)(row - MPROMPT) * DM;
    }
    return Xf;
}
template <int MODE, int RES, bool QC = false> __device__ __forceinline__ void ln_rows(bf16* V, const float* slab, const bf16* resbuf, const float* xp, const float* xs, const float* meta, float scale,
                                                                     const float* gam, const float* bet, float* Xf, bf16* Xb, float* out, int gw, int NGW, int lane, LAS unsigned char* ldsgb  , unsigned char* Xq = nullptr, float* Rs = nullptr) {
    const int nrows = MODE == 0 ? MPAD : MREAL;
    const int wv = gw & (NWAVES - 1), cu = gw / NWAVES, Gq = NGW / NWAVES, TPW = (MPAD - 8192 + Gq - 1) / Gq;
    for (int k = 0; k < TPW; ++k) { const int row = 8192 + cu * TPW + k; if (row >= nrows) break;
        asm volatile("" : "+v"(lane));
        const int pmi = (row - 8192) >> 8, rr = row & 255;
        const float* rp = RES == 1 ? nullptr : x0_row(xp, xs, meta, row);
#pragma unroll
        for (int jj = 0; jj < 2; ++jj) { const int j = wv + NWAVES * jj; const float* sp = slab + ((size_t)((pmi * 16 + j) * 8) * 256 + rr) * 256 + 4 * lane;
            f32x4 a = *(const f32x4*)sp;
#pragma unroll
            for (int ks = 1; ks < 8; ++ks) a += *(const f32x4*)(sp + (size_t)ks * 65536);
            f32x4 r = (f32x4){0.f, 0.f, 0.f, 0.f};
            if (RES == 1) { const v2u w = *(const v2u*)(resbuf + (size_t)row * DM + 4 * lane + 256 * j); r = (f32x4){bflo(w.x), bfhi(w.x), bflo(w.y), bfhi(w.y)}; } else if (rp) r = *(const f32x4*)(rp + 4 * lane + 256 * j);
            const f32x4 y = r * ALPHA + a * scale; v2u w; w.x = pg8::cvt_pk_bf16(y.x, y.y); w.y = pg8::cvt_pk_bf16(y.z, y.w);
            *(v2u*)(V + (size_t)row * DM + 4 * lane + 256 * j) = w; }
    }
    asm volatile("s_waitcnt vmcnt(0)" ::: "memory");
    __syncthreads();
    LAS f32x4* gb = (LAS f32x4*)ldsgb;
    { const int c = wv, o = 8 * lane + 512 * c;
      gb[(4 * c + 0) * 64 + lane] = *(const f32x4*)(gam + o); gb[(4 * c + 1) * 64 + lane] = *(const f32x4*)(gam + o + 4); gb[(4 * c + 2) * 64 + lane] = *(const f32x4*)(bet + o); gb[(4 * c + 3) * 64 + lane] = *(const f32x4*)(bet + o + 4); }
    __syncthreads();
    const int nmain = gw < 8192 ? (8192 - gw + NGW - 1) / NGW : 0, ntail = wv < TPW ? (TPW - wv + NWAVES - 1) / NWAVES : 0, nit = nmain + ntail;
#define LN_ROW(it) ((it) < nmain ? gw + (it) * NGW : 8192 + cu * TPW + wv + ((it) - nmain) * NWAVES)
    int it = 0;
    while (it < nit && (LN_ROW(it) >= nrows || !ln_dst<MODE>(LN_ROW(it), Xf, out))) ++it;
    v4u nw[8];
    if (it < nit) {
#pragma unroll
        for (int c = 0; c < 8; ++c) nw[c] = __builtin_nontemporal_load((const v4u*)(V + (size_t)LN_ROW(it) * DM + 8 * lane + 512 * c)); }
    while (it < nit) {
        const int row = LN_ROW(it);
        float* dst = ln_dst<MODE>(row, Xf, out);
        asm volatile("" : "+v"(lane));
        f32x4 v[16];
#pragma unroll
        for (int c = 0; c < 8; ++c) { const v4u w = nw[c];
            v[2 * c] = (f32x4){bflo(w.x), bfhi(w.x), bflo(w.y), bfhi(w.y)}; v[2 * c + 1] = (f32x4){bflo(w.z), bfhi(w.z), bflo(w.w), bfhi(w.w)}; }
        int nx = it + 1;
        while (nx < nit && (LN_ROW(nx) >= nrows || !ln_dst<MODE>(LN_ROW(nx), Xf, out))) ++nx;
        if (nx < nit) {
#pragma unroll
            for (int c = 0; c < 8; ++c) nw[c] = __builtin_nontemporal_load((const v4u*)(V + (size_t)LN_ROW(nx) * DM + 8 * lane + 512 * c)); }
        __builtin_amdgcn_sched_barrier(0);
        ln_finish<MODE, QC>(v, gb, dst, Xb + (size_t)row * DM, QC ? Xq + (size_t)row * DM : nullptr, QC ? Rs + row : nullptr, lane);
        it = nx;
    }
#undef LN_ROW
    __syncthreads();
}

__host__ __device__ __forceinline__ int pg8_units(int n, int G, int w) { return n > w ? (n - 1 - w) / G + 1 : 0; }
struct Args { const float* in[31]; float* out; unsigned char* ws; int ph_lo, ph_hi, li, pad; };
__global__ void __launch_bounds__(NWAVES * 64, 2) mk_fwd(Args args) {
    extern __shared__ __attribute__((aligned(16))) unsigned char lds_raw[];
    LAS unsigned char* lds = (LAS unsigned char*)lds_raw;
    volatile LAS unsigned* MISC = (volatile LAS unsigned*)(lds + MISC_OFF);
    const int wave = __builtin_amdgcn_readfirstlane((int)threadIdx.x >> 6);
#define PHASE_IDS const int lane = lane_now(), tid = (wave << 6) | lane, gtid = vcu * (NWAVES * 64) + tid; (void)tid; (void)gtid
    const int G = gridDim.x; const int bx = blockIdx.x; const int vcu = (G % 8 == 0) ? (bx % 8) * (G / 8) + bx / 8 : bx;
    unsigned char* ws = args.ws;
    gu32* ctl = (gu32*)(ws + WS_CTL);
    const float* x_prompt = args.in[0]; const float* x_sample = args.in[1]; const float* state_pool = args.in[2]; const float* state_conv = args.in[3]; const float* state_lru = args.in[4];
    const float* meta = args.in[5];
    float* out = args.out;
    bf16* WMIX = (bf16*)(ws + WS_WMIX); bf16* WPOOL = (bf16*)(ws + WS_WPOOL); bf16* WLRU = (bf16*)(ws + WS_WLRU); bf16* WUPP = (bf16*)(ws + WS_WUPP); bf16* WUPL = (bf16*)(ws + WS_WUPL); bf16* WOUT = (bf16*)(ws + WS_WOUT);
    bf16* WFA = (bf16*)(ws + WS_WFA); bf16* WFB = (bf16*)(ws + WS_WFB);
    bf16* XB = (bf16*)(ws + WS_XB); bf16* HB = (bf16*)(ws + WS_H); unsigned* ABW = (unsigned*)(ws + WS_A); bf16* DB = (bf16*)(ws + WS_D);
    bf16* VB = (bf16*)(ws + WS_V); bf16* MPB = (bf16*)(ws + WS_MP); bf16* X1B = (bf16*)(ws + WS_X1F); unsigned char* X1Q8 = ws + WS_X1F + 68 * MiB;     unsigned char* WG8 = ws + WS_WMIX + (size_t)INW * DM * 2;
    bf16* ZB = (bf16*)(ws + WS_Z); bf16* MB = (bf16*)(ws + WS_MB); bf16* GT = (bf16*)(ws + WS_GATES); bf16* YA = (bf16*)(ws + WS_YA); bf16* YB = (bf16*)(ws + WS_YB); float* CVB = (float*)(ws + WS_CV); float* SLAB2 = (float*)(ws + WS_H);
    float* SLAB = (float*)(ws + WS_GATES);
    unsigned* CMAX1 = (unsigned*)(ws + WS_CMAX1); unsigned* CMAX2 = (unsigned*)(ws + WS_CMAX2); unsigned* CMAXG = (unsigned*)(ws + WS_CMAXG); unsigned* CMAXZ = (unsigned*)(ws + WS_CMAXZ); bf16* WZB = (bf16*)(ws + WS_WZB);
    float* RS0 = (float*)(ws + WS_RS0); float* RS1 = (float*)(ws + WS_RS1); float* RS2 = (float*)(ws + WS_RS2);
    unsigned char* XQ0 = ws + WS_XB;            unsigned char* X2Q = X1Q8;

    { const int tid0 = (wave << 6) | lane_now(); for (int u = tid0; u < (LDS_BYTES - LDSCTL_OFF) / 4; u += NWAVES * 64) ((LAS unsigned*)(lds + LDSCTL_OFF))[u] = 0u; }
    __syncthreads();
    XcdBarrier bar = xcd_barrier_post((unsigned*)(ctl + CW_BAR) + args.li * XCD_BAR_WORDS, MISC + 8, wave == 0 && lane_now() == 0);
#define GRID_BAR() xcd_barrier(bar, wave == 0 && lane_now() == 0)
    const int lo = args.ph_lo, hi = args.ph_hi;
#define IN(k) (lo <= (k) && (k) < hi)
#define BOTH(k) (IN(k) && IN((k) + 1))
    const int gw = vcu * NWAVES + wave, NGW = G * NWAVES;
    const int NT = G * NWAVES * 64;
    LAS unsigned* scr = (LAS unsigned*)(lds + RING_OFF + wave * 16384);

    if (IN(0)) { PHASE_IDS;
        { constexpr int C0 = 64 * 86, C1 = 64 * 86, C2 = 64 * 32, C3 = 64 * 40;
          for (int it = gw; it < C0 + C1 + C2 + C3; it += NGW) {
              if (it < C0) colmax_job<true>(args.in[6], 2 * DFF, CMAX1, it, lane);
              else if (it < C0 + C1) colmax_job<true>(args.in[27], 2 * DFF, CMAX2, it - C0, lane);
              else if (it < C0 + C1 + C2) colmax_job<false>(args.in[20], NGATE, CMAXG, it - C0 - C1, lane);
              else colmax_job<false>(args.in[10], INW, CMAXZ, it - C0 - C1 - C2, lane); } }
        GRID_BAR();
        constexpr int I0 = 32 * 344  , I2 = 32 * 160  , I3 = 32 * 128  , I4 = 4 * 64, I5 = 16 * 16, I6 = 16 * 16, I7 = 64 * 96  ;
        constexpr int NITEMS = I0 + I2 + I3 + I4 + I5 + I6 + I7;
        for (int it = gw; it < NITEMS; it += NGW) {
            int r = it;
            if (r < I2) { tr_job_i8(args.in[10], DM, INW, (unsigned char*)WMIX, 0, r, scr, lane, CMAXZ); continue; } r -= I2;
            if (r < I7) { const int kb = r / 96, nb = r - kb * 96; tr_item(args.in[10], INW, WZB, DM, 64 * kb, 64 * nb, 64 * nb, scr, lane); continue; } r -= I7;
            if (r < I3) { tr_job_i8(args.in[20], DM, NGATE, WG8, 0, r, scr, lane, CMAXG); continue; } r -= I3;
            if (r < I0) { tr_job_i8(args.in[6], DM, 2 * DFF, (unsigned char*)WFA, 1, r, scr, lane, CMAX1); continue; } r -= I0;
            if (r < I4) { const int g = r >> 6; tr_job(args.in[11] + (size_t)g * 512 * 512, 512, 512, WPOOL, 0, g * 512, r & 63, scr, lane); continue; } r -= I4;
            if (r < I5) { const int b = r >> 4; tr_job(args.in[15] + (size_t)b * 256 * 256, 256, 256, WLRU, 2, b * 512, r & 15, scr, lane); continue; } r -= I5;
            { const int b = r >> 4; tr_job(args.in[17] + (size_t)b * 256 * 256, 256, 256, WLRU, 2, b * 512 + 128, r & 15, scr, lane); }
        }
        for (int row = gw; row < MPAD; row += NGW) {
            const float* src = x0_row(x_prompt, x_sample, meta, row);
            f32x4 a[16]; float mx = 0.f;
#pragma unroll
            for (int j = 0; j < 8; ++j) { a[2 * j] = (f32x4){0.f, 0.f, 0.f, 0.f}; a[2 * j + 1] = a[2 * j];
                if (src) { a[2 * j] = *(const f32x4*)(src + 512 * j + 8 * lane); a[2 * j + 1] = *(const f32x4*)(src + 512 * j + 8 * lane + 4); } }
#pragma unroll
            for (int j = 0; j < 16; ++j) mx = fmaxf(mx, fmaxf(fmaxf(fabsf(a[j].x), fabsf(a[j].y)), fmaxf(fabsf(a[j].z), fabsf(a[j].w))));
            mx = wave_max(mx); const float inv = mx > 0.f ? 127.f / mx : 0.f;
            if (lane == 0) RS0[row] = mx * (1.f / 127.f);
#pragma unroll
            for (int j = 0; j < 8; ++j) { const f32x4 p = a[2 * j] * inv, q = a[2 * j + 1] * inv;
                v2u w; w.x = pack4(q8i(p.x), q8i(p.y), q8i(p.z), q8i(p.w)); w.y = pack4(q8i(q.x), q8i(q.y), q8i(q.z), q8i(q.w));
                *(v2u*)(XQ0 + (size_t)row * DM + 512 * j + 8 * lane) = w; }
        }
        for (int i = gtid; i < LW; i += NT) CVB[i] = -8.0f * log1pf(expf(-args.in[19][i]));
        if (BOTH(0)) GRID_BAR();
    }
#define TAIL_WGS(nun) (((nun) % G) == 0 ? G : G - ((nun) % G))
#define TAIL_RANK(nun) (((nun) % G) == 0 ? bx : bx - ((nun) % G))
    if (IN(1)) { PHASE_IDS;
        pg8::Gemm g{(const bf16*)XQ0, WFA, DM / 2, DM / 2, DM / 2, 1 << 20, 0}; pg8::StaticOrder S; S.init(MPAD, 2 * DFF, G, bx);
        EpiSwigluI8 E{(unsigned char*)HB, RS0, CMAX1};
        pg8::gemm_phase<EpiSwigluI8, pg8::StaticOrder, PG8_ALIGN, PG8_SP2, 2>(lds + RING_OFF, g, S, E, wave);
        { const int tr = TAIL_RANK(34 * 86), tn = TAIL_WGS(34 * 86);
          if (tr >= 0) for (int it = tr * NWAVES + wave; it < 86 * 64; it += tn * NWAVES) { const int kb = it >> 6, nb = it & 63; tr_item8(args.in[7], DM, (unsigned char*)WFB, DFF, 128 * kb, 64 * nb, 64 * nb, scr, lane, 128.f); } }
        if (BOTH(1)) GRID_BAR();
    }
    if (IN(2)) { PHASE_IDS;
        pg8::Gemm g{HB, WFB, DFF / 2, DFF / 2, DFF / 2, 1 << 20, 0}; pg8::SplitTailOrder S; S.init(DM, DFF / 128, G, bx);
        EpiResid<0> E{VB, nullptr, x_prompt, x_sample, meta, 0.5f / 512.f, SLAB};
        pg8::gemm_phase<EpiResid<0>, pg8::SplitTailOrder, PG8_ALIGN, PG8_SP2, true>(lds + RING_OFF, g, S, E, wave);
        if (BOTH(2)) GRID_BAR();
    }
    if (IN(3)) { PHASE_IDS;
        ln_rows<0, 0, true>(VB, SLAB, nullptr, x_prompt, x_sample, meta, 0.5f / 512.f, args.in[8], args.in[9], out, X1B, nullptr, gw, NGW, lane, lds + RING_OFF, X1Q8, RS1);
        for (int it = gw; it < 32 * 344; it += NGW) tr_job_i8(args.in[27], DM, 2 * DFF, (unsigned char*)WFA, 1, it, scr, lane, CMAX2);
        if (BOTH(3)) GRID_BAR();
    }
    if (IN(4)) { PHASE_IDS;
        constexpr int NZ8 = 34 * 16 + 29 * 24, NZB = 5 * 24, NGT = 34 * 32;
        const int c8 = bx, cb = ((bx - NZ8) % G + G) % G, cg = ((bx - NZ8 - NZB) % G + G) % G;
        { pg8::Gemm g{(const bf16*)X1Q8, WMIX, DM / 2, DM / 2, DM / 2, 1 << 20, 0}; pg8::Z8Order S; S.init(G, c8);
          EpiZ<true> E{ZB, RS1, CMAXZ};
          pg8::gemm_phase<EpiZ<true>, pg8::Z8Order, PG8_ALIGN, PG8_SP2, 2>(lds + RING_OFF, g, S, E, wave); }
        { pg8::Gemm g{X1B, WZB, DM, DM, DM, 1 << 20, 0}; pg8::ZbOrder S; S.init(G, cb);
          EpiZ<false> E{ZB, nullptr, nullptr};
          pg8::gemm_phase<EpiZ<false>, pg8::ZbOrder, PG8_ALIGN, PG8_SP2>(lds + RING_OFF, g, S, E, wave); }
        { pg8::Gemm g{(const bf16*)X1Q8, (const bf16*)WG8, DM / 2, DM / 2, DM / 2, 1 << 20, 0}; pg8::StaticOrder S; S.init(MPAD, NGATE, G, cg);
          EpiGate E{GT, args.in[21], RS1, CMAXG};
          pg8::gemm_phase<EpiGate, pg8::StaticOrder, PG8_ALIGN, PG8_SP2, 2>(lds + RING_OFF, g, S, E, wave); }
        {
          const bool conv = G == 256 && bx >= 80; const int tn = G == 256 ? 176 : 0, tr = bx - 80;
          const int lane = lane_now();
          if (tn > 0 && conv && tr >= 0) for (int it = tr * NWAVES + wave; it < 32 * 64 + 2 * 64 * 64; it += tn * NWAVES) {
              if (it < 32 * 64) tr_job(args.in[22], PW, DM, WUPP, 0, 0, it, scr, lane);
              else if (it < 32 * 64 + 64 * 64) tr_job(args.in[23], LW, DM, WUPL, 0, 0, it - 32 * 64, scr, lane);
              else tr_job(args.in[24], DM, DM, WOUT, 0, 0, it - 32 * 64 - 64 * 64, scr, lane); }
          else if (tn <= 0) for (int it = gw; it < 32 * 64 + 2 * 64 * 64; it += NGW) {
              if (it < 32 * 64) tr_job(args.in[22], PW, DM, WUPP, 0, 0, it, scr, lane);
              else if (it < 32 * 64 + 64 * 64) tr_job(args.in[23], LW, DM, WUPL, 0, 0, it - 32 * 64, scr, lane);
              else tr_job(args.in[24], DM, DM, WOUT, 0, 0, it - 32 * 64 - 64 * 64, scr, lane); } }
        if (BOTH(4)) GRID_BAR();
    }
    if (IN(5)) { PHASE_IDS;
        for (int i = gtid; i < 4 * 86 * 256 + 8 * 2 * 256; i += NT) {
            int v, t0, R, rowbase, nh; const float* hist = nullptr;
            if (i < 4 * 86 * 256) { v = i & 255; const int q = i >> 8, seq = q / 86; t0 = (q - seq * 86) * 24; R = 24; rowbase = seq * TP; nh = 0; }
            else { const int j = i - 4 * 86 * 256; v = j & 255; const int q = j >> 8, sb = q >> 1; t0 = (q & 1) * 16; R = 16; rowbase = MPROMPT + sb * TS; nh = 15; hist = state_pool + (size_t)sb * 15 * PW; }
            const int c0 = v * 8, w = 2 << (v >> 6);
            const bf16* zp = ZB + (size_t)rowbase * INW + c0;
            float s[8];
#pragma unroll
            for (int e = 0; e < 8; ++e) s[e] = 0.f;
            for (int k = 1; k < w; ++k) { const int tt = t0 - k;
                if (tt >= 0) { const v4u zw = *(const v4u*)(zp + (size_t)tt * INW);
                    s[0] += bflo(zw.x); s[1] += bfhi(zw.x); s[2] += bflo(zw.y); s[3] += bfhi(zw.y); s[4] += bflo(zw.z); s[5] += bfhi(zw.z); s[6] += bflo(zw.w); s[7] += bfhi(zw.w); }
                else if (hist) { const float* hp = hist + (size_t)(15 + tt) * PW + c0; const f32x4 a = *(const f32x4*)hp, b = *(const f32x4*)(hp + 4);
                    s[0] += a.x; s[1] += a.y; s[2] += a.z; s[3] += a.w; s[4] += b.x; s[5] += b.y; s[6] += b.z; s[7] += b.w; } }
            for (int r = 0; r < R; ++r) { const int t = t0 + r;
                const v4u zw = *(const v4u*)(zp + (size_t)t * INW);
                const float cur[8] = {bflo(zw.x), bfhi(zw.x), bflo(zw.y), bfhi(zw.y), bflo(zw.z), bfhi(zw.z), bflo(zw.w), bfhi(zw.w)};
                const int cnt = (nh + 1 + t) < w ? (nh + 1 + t) : w; const float inv = 1.0f / (float)cnt;
                float d[8];
#pragma unroll
                for (int e = 0; e < 8; ++e) { s[e] += cur[e]; d[e] = s[e] * inv - cur[e]; }
                v4u o; o.x = pk2(d[0], d[1]); o.y = pk2(d[2], d[3]); o.z = pk2(d[4], d[5]); o.w = pk2(d[6], d[7]);
                *(v4u*)(DB + (size_t)(rowbase + t) * PW + c0) = o;
                const int tt = t - w + 1;
                if (tt >= 0) { const v4u ow = *(const v4u*)(zp + (size_t)tt * INW);
                    s[0] -= bflo(ow.x); s[1] -= bfhi(ow.x); s[2] -= bflo(ow.y); s[3] -= bfhi(ow.y); s[4] -= bflo(ow.z); s[5] -= bfhi(ow.z); s[6] -= bflo(ow.w); s[7] -= bfhi(ow.w); }
                else if (hist) { const float* hp = hist + (size_t)(15 + tt) * PW + c0; const f32x4 a = *(const f32x4*)hp, b = *(const f32x4*)(hp + 4);
                    s[0] -= a.x; s[1] -= a.y; s[2] -= a.z; s[3] -= a.w; s[4] -= b.x; s[5] -= b.y; s[6] -= b.z; s[7] -= b.w; } }
        }
        const float* conv_w = args.in[13]; const float* conv_b = args.in[14];
        for (int i = gtid; i < 4 * 48 * 512 + 8 * 2 * 512; i += NT) {
            int v, t0, R, rowbase; const float* hist = nullptr;
            if (i < 4 * 48 * 512) { v = i & 511; const int q = i >> 9, seq = q / 48; t0 = (q - seq * 48) * 43; R = 43; rowbase = seq * TP; }
            else { const int j = i - 4 * 48 * 512; v = j & 511; const int q = j >> 9, sb = q >> 1; t0 = (q & 1) * 16; R = 16; rowbase = MPROMPT + sb * TS; hist = state_conv + (size_t)sb * 3 * LW; }
            const int c0 = v * 8;
            const bf16* zp = ZB + (size_t)rowbase * INW + PW + c0;
            float wk[4][8], bb[8], zh[3][8];
#pragma unroll
            for (int k = 0; k < 4; ++k) { const f32x4 w0 = *(const f32x4*)(conv_w + (size_t)k * LW + c0), w1 = *(const f32x4*)(conv_w + (size_t)k * LW + c0 + 4);
                wk[k][0] = w0.x; wk[k][1] = w0.y; wk[k][2] = w0.z; wk[k][3] = w0.w; wk[k][4] = w1.x; wk[k][5] = w1.y; wk[k][6] = w1.z; wk[k][7] = w1.w; }
            { const f32x4 b0 = *(const f32x4*)(conv_b + c0), b1 = *(const f32x4*)(conv_b + c0 + 4); bb[0] = b0.x; bb[1] = b0.y; bb[2] = b0.z; bb[3] = b0.w; bb[4] = b1.x; bb[5] = b1.y; bb[6] = b1.z; bb[7] = b1.w; }
#pragma unroll
            for (int k = 0; k < 3; ++k) { const int tt = t0 - 3 + k;
#pragma unroll
                for (int e = 0; e < 8; ++e) zh[k][e] = 0.f;
                if (tt >= 0) { const v4u zw = *(const v4u*)(zp + (size_t)tt * INW);
                    zh[k][0] = bflo(zw.x); zh[k][1] = bfhi(zw.x); zh[k][2] = bflo(zw.y); zh[k][3] = bfhi(zw.y); zh[k][4] = bflo(zw.z); zh[k][5] = bfhi(zw.z); zh[k][6] = bflo(zw.w); zh[k][7] = bfhi(zw.w); }
                else if (hist) { const float* hp = hist + (size_t)(3 + tt) * LW + c0; const f32x4 h0 = *(const f32x4*)hp, h1 = *(const f32x4*)(hp + 4);
                    zh[k][0] = h0.x; zh[k][1] = h0.y; zh[k][2] = h0.z; zh[k][3] = h0.w; zh[k][4] = h1.x; zh[k][5] = h1.y; zh[k][6] = h1.z; zh[k][7] = h1.w; } }
            for (int r = 0; r < R; ++r) { const int t = t0 + r;
                const v4u zw = *(const v4u*)(zp + (size_t)t * INW);
                const float cur[8] = {bflo(zw.x), bfhi(zw.x), bflo(zw.y), bfhi(zw.y), bflo(zw.z), bfhi(zw.z), bflo(zw.w), bfhi(zw.w)};
                float a[8];
#pragma unroll
                for (int e = 0; e < 8; ++e) { a[e] = bb[e] + zh[0][e] * wk[0][e] + zh[1][e] * wk[1][e] + zh[2][e] * wk[2][e] + cur[e] * wk[3][e]; zh[0][e] = zh[1][e]; zh[1][e] = zh[2][e]; zh[2][e] = cur[e]; }
                v4u o; o.x = pk2(a[0], a[1]); o.y = pk2(a[2], a[3]); o.z = pk2(a[4], a[5]); o.w = pk2(a[6], a[7]);
                *(v4u*)(XB + (size_t)(rowbase + t) * LW + c0) = o; }
        }
        for (int i = gtid; i < NBP * 15 * PW; i += NT) { const int c = i % PW, j = (i / PW) % 15, b = i / (15 * PW); out[O_PP + i] = __builtin_bit_cast(float, (unsigned)ZB[(size_t)(b * TP + TP - 15 + j) * INW + c] << 16); }
        for (int i = gtid; i < NBP * 3 * LW; i += NT) { const int c = i % LW, j = (i / LW) % 3, b = i / (3 * LW); out[O_CP + i] = __builtin_bit_cast(float, (unsigned)ZB[(size_t)(b * TP + TP - 3 + j) * INW + PW + c] << 16); }
        for (int i = gtid; i < NBS * 15 * PW; i += NT) { const int c = i % PW, j = (i / PW) % 15, b = i / (15 * PW); out[O_PS + i] = __builtin_bit_cast(float, (unsigned)ZB[(size_t)(MPROMPT + b * TS + TS - 15 + j) * INW + c] << 16); }
        for (int i = gtid; i < NBS * 3 * LW; i += NT) { const int c = i % LW, j = (i / LW) % 3, b = i / (3 * LW); out[O_CS + i] = __builtin_bit_cast(float, (unsigned)ZB[(size_t)(MPROMPT + b * TS + TS - 3 + j) * INW + PW + c] << 16); }
        if (BOTH(5)) GRID_BAR();
    }
    if (IN(6)) { PHASE_IDS;
        { pg8::Gemm g{DB, WPOOL, PW, 512, 512, 2, 512}; pg8::StaticOrder S; S.init(MPAD, PW, G, bx);
          EpiPool E{YA, args.in[12]};
          pg8::gemm_phase<EpiPool, pg8::StaticOrder, PG8_ALIGN, PG8_SP2>(lds + RING_OFF, g, S, E, wave); }
        { pg8::Gemm g{XB, WLRU, LW, 256, 256, 2, 256}; pg8::StaticOrder S; S.init(MPAD, 2 * LW, G, G - 1 - bx);
          EpiLru E{ABW, XB, args.in[16], args.in[18], CVB};
          pg8::gemm_phase<EpiLru, pg8::StaticOrder, PG8_ALIGN, PG8_SP2>(lds + RING_OFF, g, S, E, wave); }
        if (BOTH(6)) GRID_BAR();
    }
    if (IN(7)) { PHASE_IDS;
        LAS float* cs = (LAS float*)(lds + RING_OFF);
        for (int item = bx; item < NBP * 64; item += G) {
            const int seq = item >> 6, ch = (item & 63) * 64 + lane, c = wave;
            const size_t r0 = (size_t)seq * TP + (size_t)c * 258;
            const unsigned* ap = ABW + r0 * LW + ch;
            float h = 0.f, S = 0.f;
            for (int s = 0; s < 240; s += 24) scan_blk1<24>(ap + (size_t)s * LW, h, S);
            scan_blk1<18>(ap + (size_t)240 * LW, h, S);
            cs[(c * 64 + lane) * 2] = __expf(S); cs[(c * 64 + lane) * 2 + 1] = h;
            __syncthreads();
            float hc = 0.f;
            for (int k = 0; k < c; ++k) hc = cs[(k * 64 + lane) * 2] * hc + cs[(k * 64 + lane) * 2 + 1];
            __syncthreads();
            h = hc;
            const bf16* gp = ZB + r0 * INW + (PW + LW) + ch; bf16* yp = YB + r0 * LW + ch;
            for (int s = 0; s < 256; s += 16) scan_blk3<16>(ap + (size_t)s * LW, gp + (size_t)s * INW, yp + (size_t)s * LW, h);
            scan_blk3<2>(ap + (size_t)256 * LW, gp + (size_t)256 * INW, yp + (size_t)256 * LW, h);
            if (c == 7) out[O_LP + (size_t)seq * LW + ch] = h;
        }
        for (int base = bx * 128; base < NBS * LW; base += G * 128) {
            if (tid < 128) { const int idx = base + tid, sb = idx >> 12, ch = idx & 4095;
                float h = state_lru[idx];
                const size_t r0 = (size_t)MPROMPT + (size_t)sb * TS;
                for (int s = 0; s < TS; s += 16) scan_blk3<16>(ABW + (r0 + s) * LW + ch, ZB + (r0 + s) * INW + (PW + LW) + ch, YB + (r0 + s) * LW + ch, h);
                out[O_LS + idx] = h; }
        }
        if (BOTH(7)) GRID_BAR();
    }
    if (IN(8)) { PHASE_IDS;
        pg8::Gemm g{YA, WUPP, PW, PW, PW, 1 << 20, 0}; pg8::SplitTailOrder S; S.init(DM, PW / 64, G, bx);
        EpiUpPool E{MPB, GT, SLAB2};
        pg8::gemm_phase<EpiUpPool, pg8::SplitTailOrder, PG8_ALIGN, PG8_SP2>(lds + RING_OFF, g, S, E, wave);
        if (!BOTH(8)) {} else VM_WAIT();
    }
    if (IN(9)) { PHASE_IDS;
        pg8::Gemm g{YB, WUPL, LW, LW, LW, 1 << 20, 0}; pg8::SplitTailOrder S; S.init(DM, LW / 64, G, bx);
        EpiUpLru E{MB, MPB, GT, SLAB2 + (size_t)256 * 65536, SLAB2};
        pg8::gemm_phase<EpiUpLru, pg8::SplitTailOrder, PG8_ALIGN, PG8_SP2>(lds + RING_OFF, g, S, E, wave);
        GRID_BAR();
        for (int i = gtid; i < 512 * 1024; i += NT) {
            const int row = 8192 + (i >> 10), col = (i & 1023) * 4;
            const float* sp = SLAB2 + (size_t)(256 + (((row - 8192) >> 8) * 16 + (col >> 8)) * 8) * 65536 + (size_t)(row & 255) * 256 + (col & 255);
            f32x4 a = *(const f32x4*)sp;
#pragma unroll
            for (int ks = 1; ks < 8; ++ks) a += *(const f32x4*)(sp + (size_t)ks * 65536);
            v2u w; w.x = pg8::cvt_pk_bf16(a.x, a.y); w.y = pg8::cvt_pk_bf16(a.z, a.w);
            *(v2u*)(MB + (size_t)row * DM + col) = w;
        }
        if (BOTH(9)) GRID_BAR();
    }
    if (IN(10)) { PHASE_IDS;
        pg8::Gemm g{MB, WOUT, DM, DM, DM, 1 << 20, 0}; pg8::SplitTailOrder S; S.init(DM, DM / 64, G, bx);
        EpiResid<1> E{VB, X1B, nullptr, nullptr, nullptr, 1.0f, SLAB};
        pg8::gemm_phase<EpiResid<1>, pg8::SplitTailOrder, PG8_ALIGN, PG8_SP2>(lds + RING_OFF, g, S, E, wave);
        if (BOTH(10)) GRID_BAR();
    }
    if (IN(11)) { PHASE_IDS;
        ln_rows<0, 1, true>(VB, SLAB, X1B, nullptr, nullptr, nullptr, 1.0f, args.in[25], args.in[26], out, XB, nullptr, gw, NGW, lane, lds + RING_OFF, X2Q, RS2);
        if (BOTH(11)) GRID_BAR();
    }
    if (IN(12)) { PHASE_IDS;
        pg8::Gemm g{(const bf16*)X2Q, WFA, DM / 2, DM / 2, DM / 2, 1 << 20, 0}; pg8::StaticOrder S; S.init(MPAD, 2 * DFF, G, bx);
        EpiSwigluI8 E{(unsigned char*)HB, RS2, CMAX2};
        pg8::gemm_phase<EpiSwigluI8, pg8::StaticOrder, PG8_ALIGN, PG8_SP2, 2>(lds + RING_OFF, g, S, E, wave);
        { const int tr = TAIL_RANK(34 * 86), tn = TAIL_WGS(34 * 86);
          if (tr >= 0) for (int it = tr * NWAVES + wave; it < 86 * 64; it += tn * NWAVES) { const int kb = it >> 6, nb = it & 63; tr_item8(args.in[28], DM, (unsigned char*)WFB, DFF, 128 * kb, 64 * nb, 64 * nb, scr, lane, 128.f); } }
        if (BOTH(12)) GRID_BAR();
    }
    if (IN(13)) { PHASE_IDS;
        pg8::Gemm g{HB, WFB, DFF / 2, DFF / 2, DFF / 2, 1 << 20, 0}; pg8::SplitTailOrder S; S.init(DM, DFF / 128, G, bx);
        EpiResid<1> E{VB, XB, nullptr, nullptr, nullptr, 0.5f / 512.f, SLAB};
        pg8::gemm_phase<EpiResid<1>, pg8::SplitTailOrder, PG8_ALIGN, PG8_SP2, true>(lds + RING_OFF, g, S, E, wave);
        if (BOTH(13)) GRID_BAR();
    }
    if (IN(14)) { PHASE_IDS;
        ln_rows<1, 1>(VB, SLAB, XB, nullptr, nullptr, nullptr, 0.5f / 512.f, args.in[29], args.in[30], nullptr, XB, out, gw, NGW, lane, lds + RING_OFF);
    }
#undef IN
#undef BOTH
#undef GRID_BAR
}

#ifndef MK_N_LAUNCHES
#define MK_N_LAUNCHES 1
#endif
extern "C" void kernel_launch(void* const* d_in, const int* in_sizes, int n_in, void* d_out, int out_size, void* d_ws, size_t ws_size, hipStream_t stream) {
    static int grid = 0;
    if (grid == 0) {
        if (n_in != 31 || (size_t)out_size != O_END || ws_size < WS_END) { fprintf(stderr, "kernel_launch: unexpected problem (n_in %d, out %d, ws %zu, need %zu); nothing launched\n", n_in, out_size, ws_size, (size_t)WS_END); grid = -1; return; }
        int dev = 0, cus = 0, per_cu = 0;
        if (hipGetDevice(&dev) != hipSuccess || hipDeviceGetAttribute(&cus, hipDeviceAttributeMultiprocessorCount, dev) != hipSuccess) { fprintf(stderr, "kernel_launch: device query failed\n"); grid = -1; return; }
        if (hipFuncSetAttribute((const void*)mk_fwd, hipFuncAttributeMaxDynamicSharedMemorySize, LDS_BYTES) != hipSuccess) { fprintf(stderr, "kernel_launch: hipFuncSetAttribute failed\n"); grid = -1; return; }
        if (hipOccupancyMaxActiveBlocksPerMultiprocessor(&per_cu, (const void*)mk_fwd, NWAVES * 64, LDS_BYTES) != hipSuccess || per_cu < 1)
            fprintf(stderr, "kernel_launch: note: occupancy query reports %d workgroups per CU\n", per_cu);
        (void)hipGetLastError();
        grid = cus;
    }
    if (grid < 0) return;
    if (hipMemsetAsync((char*)d_ws + WS_CTL, 0, CTL_ZERO_BYTES, stream) != hipSuccess) { fprintf(stderr, "kernel_launch: memset failed\n"); return; }
    Args a{};
    for (int i = 0; i < 31; ++i) a.in[i] = (const float*)d_in[i];
    a.out = (float*)d_out; a.ws = (unsigned char*)d_ws;
#if MK_N_LAUNCHES == 1
    a.ph_lo = 0; a.ph_hi = NPHASE; a.li = 0;
    hipLaunchKernelGGL(mk_fwd, dim3(grid), dim3(NWAVES * 64), LDS_BYTES, stream, a);
#else
    for (int li = 0; li < NPHASE; ++li) { a.ph_lo = li; a.ph_hi = li + 1; a.li = 0; hipLaunchKernelGGL(mk_fwd, dim3(grid), dim3(NWAVES * 64), LDS_BYTES, stream, a); }
#endif
    const hipError_t le = hipPeekAtLastError();
    if (le != hipSuccess) fprintf(stderr, "kernel_launch: launch failed: %s\n", hipGetErrorName(le));
}
```

```cpp
#include <hip/hip_runtime.h>
#include <cstdio>
#include <cstdint>

__device__ __forceinline__ int lane_now() { int l; asm volatile("v_mbcnt_lo_u32_b32 %0, -1, 0\n\tv_mbcnt_hi_u32_b32 %0, -1, %0" : "=v"(l)); return l; }
namespace pg8 {
#define PG8_LAS __attribute__((address_space(3)))
typedef unsigned short bf16_t;
typedef short bf16x8 __attribute__((ext_vector_type(8)));
typedef float f32x4 __attribute__((ext_vector_type(4)));
typedef unsigned u32x4 __attribute__((ext_vector_type(4)));
constexpr int BM = 256, BK = 64, HALF = 128, HTB = HALF * BK * 2  , STAGE_BYTES = 8 * HTB, NXCD = 8, WGM = 8;

__host__ __device__ __forceinline__ int lds_byte(int r, int c) { const int st = (r >> 4) * 2 + (c >> 5), rr = r & 15, cc = c & 31, ob = rr * 64 + cc * 2; return st * 1024 + (ob ^ (((ob >> 9) & 1) << 5)); }
__host__ __device__ __forceinline__ void stage_rc(int b, int& R, int& C) { const int st = b / 1024, sb = b % 1024, swz = sb ^ (((sb >> 9) & 1) << 5); R = (st >> 1) * 16 + swz / 64; C = (st & 1) * 32 + (swz % 64) / 2; }
__host__ __device__ __forceinline__ int perm32(int rho) { const int n = rho >> 4, i = rho & 15; return 8 * (i >> 2) + 4 * n + (i & 3); }

struct Unit { int pm, pn, kt0, nk, slab; };
struct Gemm { const bf16_t* A; const bf16_t* Bt; int lda, ldb, K, tpg, agoff; };

struct StaticOrder {
    int nM, nN, nwg, G, c;
    __host__ __device__ void init(int M, int N, int G_, int c_) { nM = M / BM; nN = N / BM; nwg = nM * nN; G = G_; c = c_; }
    __host__ __device__ bool next(int i, Unit& u) const { return at((long)i * G + c, u); }
    __host__ __device__ bool at(long L, Unit& u) const {
        if (L >= nwg) return false;
        int wgid = (int)L; { const int q = nwg / NXCD, r = nwg % NXCD, xcd = wgid % NXCD, off = wgid / NXCD; wgid = (xcd < r ? xcd * (q + 1) : r * (q + 1) + (xcd - r) * q) + off; }
        const int nig = WGM * nN, gid = wgid / nig, fm = gid * WGM, gsz = (nM - fm) < WGM ? (nM - fm) : WGM;
        u.pm = fm + ((wgid % nig) % gsz); u.pn = (wgid % nig) / gsz; u.kt0 = 0; u.nk = -1; u.slab = -1; return true;
    }
    __device__ __forceinline__ void a_ready(const Unit&) const {}
    __device__ __forceinline__ void done(const Unit&) const {}
};

typedef float f32x2_t __attribute__((ext_vector_type(2)));
typedef __bf16 bf16x2_t __attribute__((ext_vector_type(2)));
struct SplitTailOrder {
    StaticOrder so; int nN, base, rem2;
    __host__ __device__ void init(int N, int ktiles, int G_, int c_) { so.init(32 * BM, N, G_, c_); nN = N / BM; base = (ktiles / 8) & ~1; rem2 = (ktiles - 8 * base) / 2; }
    __host__ __device__ bool next(int i, Unit& u) const {
        const long L = (long)i * so.G + so.c;
        if (L < so.nwg) return so.next(i, u);
        const int Lp = (int)(L - so.nwg); if (Lp >= 2 * nN * 8) return false;
        const int ks = Lp & 7, tile = Lp >> 3;
        u.pm = 32 + tile / nN; u.pn = tile % nN; u.kt0 = ks * base + 2 * (ks < rem2 ? ks : rem2); u.nk = base + (ks < rem2 ? 2 : 0); u.slab = tile * 8 + ks; return true;
    }
    __device__ __forceinline__ void a_ready(const Unit&) const {}
    __device__ __forceinline__ void done(const Unit&) const {}
};

struct Z8Order {
    StaticOrder sa, sb; int G, c;
    __host__ __device__ void init(int G_, int c_) { G = G_; c = c_; sa.init(34 * BM, 16 * BM, G_, 0); sb.init(29 * BM, 24 * BM, G_, 0); }
    __host__ __device__ bool next(int i, Unit& u) const {
        const long L = (long)i * G + c;
        if (L >= sb.nwg) { if (!sa.at(L - sb.nwg, u)) return false; u.pn += 24; return true; }
        sb.at(L, u);
        u.pm += (u.pm >= 8) ? 1 : 0; u.pm += (u.pm >= 16) ? 1 : 0; u.pm += (u.pm >= 24) ? 1 : 0; return true;
    }
    __device__ __forceinline__ void a_ready(const Unit&) const {}
    __device__ __forceinline__ void done(const Unit&) const {}
};
struct ZbOrder {
    StaticOrder so;
    __host__ __device__ void init(int G_, int c_) { so.init(5 * BM, 24 * BM, G_, c_); }
    __host__ __device__ bool next(int i, Unit& u) const { if (!so.next(i, u)) return false; u.pm = u.pm < 3 ? 8 * (u.pm + 1) : 29 + u.pm; return true; }
    __device__ __forceinline__ void a_ready(const Unit&) const {}
    __device__ __forceinline__ void done(const Unit&) const {}
};

__device__ __forceinline__ unsigned cvt_pk_bf16(float lo, float hi) { const f32x2_t v = {lo, hi}; return __builtin_bit_cast(unsigned, __builtin_convertvector(v, bf16x2_t)); }

typedef short s16x16 __attribute__((ext_vector_type(16)));
typedef int i32x8 __attribute__((ext_vector_type(8)));
typedef int i32x4 __attribute__((ext_vector_type(4)));
template <class Epi, class Sched, bool ALIGN_EPI = false, bool SP2 = false, int QT = 0>
__device__ __forceinline__ void gemm_phase(PG8_LAS unsigned char* lds, const Gemm g, const Sched& S, const Epi& E, const int wid  ) {
    const int lane = lane_now(), tid = (wid << 6) | lane, wr = wid >> 2, wc = wid & 3, fr = lane & 15, fq = lane >> 4;
    int Kop = g.K; asm volatile("" : "+s"(Kop));
    const int K = Kop, nt_full = K / BK;
    unsigned voffA[2], voffB[2];
#pragma unroll
    for (int i = 0; i < 2; ++i) { int R, C; stage_rc(tid * 16 + i * 8192, R, C); const int Rb = Epi::PERM ? ((R & ~31) + perm32(R & 31)) : R;
        voffA[i] = (unsigned)(R * g.lda + C) * 2u; voffB[i] = (unsigned)(Rb * g.ldb + C) * 2u; }
    const __amdgpu_buffer_rsrc_t rsA = __builtin_amdgcn_make_buffer_rsrc((void*)g.A, (short)0, 0x7fffffff, 0x00020000), rsB = __builtin_amdgcn_make_buffer_rsrc((void*)g.Bt, (short)0, 0x7fffffff, 0x00020000);
    const unsigned kstep = (unsigned)(BK * 2);
    const unsigned hstepA = (unsigned)HALF * g.lda * 2, hstepB = (unsigned)HALF * g.ldb * 2;
    const unsigned tstepA = 2 * hstepA, tstepB = 2 * hstepB;
    const unsigned ldsw = (unsigned)wid * 1024u;
    const int aoff = lds_byte(wr * 64 + fr, fq * 8), boff = lds_byte(wc * 32 + fr, fq * 8);
#define PG8_UA(u) ((unsigned)(u).pm * tstepA + (unsigned)((u).pn / g.tpg) * (unsigned)g.agoff * 2u)
#define PG8_UB(u) ((unsigned)(u).pn * tstepB)
#define PG8_SA(b, h) (((b) * 2 + (h)) * HTB)
#define PG8_SB(b, h) ((4 + (b) * 2 + (h)) * HTB)
#define PG8_STAGE(bufoff, soff, voff, rs) do { _Pragma("unroll") for (int _i = 0; _i < 2; ++_i) \
        __builtin_amdgcn_raw_ptr_buffer_load_lds(rs, (PG8_LAS unsigned*)(lds + (bufoff) + ldsw + _i * 8192), 16, (voff)[_i], (int)(soff), 0, 0); } while (0)
#define PG8_LDA(dst, b, h) do { _Pragma("unroll") for (int m = 0; m < 4; ++m) _Pragma("unroll") for (int k = 0; k < 2; ++k) dst[m][k] = *(const PG8_LAS bf16x8*)(lds + PG8_SA(b, h) + aoff + m * 2048 + k * 1024); } while (0)
#define PG8_LDB(dst, b, h) do { _Pragma("unroll") for (int n = 0; n < 2; ++n) _Pragma("unroll") for (int k = 0; k < 2; ++k) dst[n][k] = *(const PG8_LAS bf16x8*)(lds + PG8_SB(b, h) + boff + n * 2048 + k * 1024); } while (0)
#define PG8_CAT(a, b) __builtin_bit_cast(i32x8, __builtin_shufflevector(a, b, 0, 1, 2, 3, 4, 5, 6, 7, 8, 9, 10, 11, 12, 13, 14, 15))
#define PG8_MMA(ai, bj, At, Bt) do { __builtin_amdgcn_s_setprio(1); if constexpr (QT == 1) { _Pragma("unroll") for (int m = 0; m < 4; ++m) _Pragma("unroll") for (int n = 0; n < 2; ++n) \
        acc[ai][bj][m][n] = __builtin_amdgcn_mfma_scale_f32_16x16x128_f8f6f4(PG8_CAT(Bt[n][0], Bt[n][1]), PG8_CAT(At[m][0], At[m][1]), acc[ai][bj][m][n], 0, 0, 0, 127, 0, 127); } else if constexpr (QT == 2) { \
        _Pragma("unroll") for (int m = 0; m < 4; ++m) _Pragma("unroll") for (int n = 0; n < 2; ++n) _Pragma("unroll") for (int k = 0; k < 2; ++k) \
        acc[ai][bj][m][n] = __builtin_bit_cast(f32x4, __builtin_amdgcn_mfma_i32_16x16x64_i8(__builtin_bit_cast(i32x4, Bt[n][k]), __builtin_bit_cast(i32x4, At[m][k]), __builtin_bit_cast(i32x4, acc[ai][bj][m][n]), 0, 0, 0)); } else { \
        _Pragma("unroll") for (int m = 0; m < 4; ++m) _Pragma("unroll") for (int n = 0; n < 2; ++n) _Pragma("unroll") for (int k = 0; k < 2; ++k) \
        acc[ai][bj][m][n] = __builtin_amdgcn_mfma_f32_16x16x32_bf16(Bt[n][k], At[m][k], acc[ai][bj][m][n], 0, 0, 0); } __builtin_amdgcn_s_setprio(0); } while (0)
#define PG8_WAIT_V(n) asm volatile("s_waitcnt vmcnt(" #n ")" ::: "memory")
#define PG8_WAIT_L(n) asm volatile("s_waitcnt lgkmcnt(" #n ")" ::: "memory")
#define PG8_BAR __builtin_amdgcn_s_barrier()
#define PG8_SCHED __builtin_amdgcn_sched_barrier(0)
    Unit cur, nxt; int ui = 0;
    if (!S.next(0, cur)) return;
    f32x4 acc[2][2][4][2];
#pragma unroll
    for (int a = 0; a < 2; ++a)
#pragma unroll
        for (int b = 0; b < 2; ++b)
#pragma unroll
            for (int m = 0; m < 4; ++m)
#pragma unroll
                for (int n = 0; n < 2; ++n) acc[a][b][m][n] = (f32x4){0.f, 0.f, 0.f, 0.f};
    bf16x8 At[4][2], B0[2][2], B1[2][2];
    unsigned cA = PG8_UA(cur) + (unsigned)cur.kt0 * kstep, cB = PG8_UB(cur) + (unsigned)cur.kt0 * kstep;
    int nt = cur.nk < 0 ? nt_full : cur.nk;
    S.a_ready(cur);
    if constexpr (SP2) {
        PG8_STAGE(PG8_SB(0, 0), cB, voffB, rsB); PG8_STAGE(PG8_SB(0, 1), cB + hstepB, voffB, rsB); PG8_STAGE(PG8_SA(0, 0), cA, voffA, rsA); PG8_STAGE(PG8_SA(0, 1), cA + hstepA, voffA, rsA);
        if (wr == 1) PG8_BAR;
        PG8_WAIT_V(2); PG8_BAR;
        PG8_STAGE(PG8_SB(1, 0), cB + kstep, voffB, rsB); PG8_STAGE(PG8_SA(1, 0), cA + kstep, voffA, rsA); PG8_STAGE(PG8_SB(1, 1), cB + hstepB + kstep, voffB, rsB);
        PG8_WAIT_V(6); PG8_BAR;
    } else {
        PG8_STAGE(PG8_SB(0, 0), cB, voffB, rsB); PG8_STAGE(PG8_SA(0, 0), cA, voffA, rsA); PG8_STAGE(PG8_SB(0, 1), cB + hstepB, voffB, rsB); PG8_STAGE(PG8_SA(0, 1), cA + hstepA, voffA, rsA);
        if (wr == 1) PG8_BAR;
        PG8_WAIT_V(4); PG8_BAR;
        PG8_STAGE(PG8_SB(1, 0), cB + kstep, voffB, rsB); PG8_STAGE(PG8_SA(1, 0), cA + kstep, voffA, rsA); PG8_STAGE(PG8_SB(1, 1), cB + hstepB + kstep, voffB, rsB);
        PG8_WAIT_V(6); PG8_BAR;
    }
    for (;;) {
        const bool has_next = S.next(ui + 1, nxt);
        const unsigned nA = has_next ? PG8_UA(nxt) + (unsigned)nxt.kt0 * kstep : cA, nB = has_next ? PG8_UB(nxt) + (unsigned)nxt.kt0 * kstep : cB;
        for (int t = 0; t < nt; t += 2) {
            const bool last = (t == nt - 2);
            const unsigned a1 = cA + (unsigned)(t + 1) * kstep;
            const unsigned a2 = last ? nA : cA + (unsigned)(t + 2) * kstep, b2 = last ? nB : cB + (unsigned)(t + 2) * kstep;
            const unsigned a3 = a2 + kstep, b3 = b2 + kstep;
            if (last && has_next) S.a_ready(nxt);
            if constexpr (SP2) {
            PG8_LDB(B0, 0, 0); PG8_LDB(B1, 0, 1); PG8_SCHED; PG8_LDA(At, 0, 0); PG8_STAGE(PG8_SA(1, 1), a1 + hstepA, voffA, rsA);
            PG8_WAIT_V(8); PG8_WAIT_L(0); PG8_BAR; PG8_MMA(0, 0, At, B0); PG8_MMA(0, 1, At, B1); PG8_BAR; PG8_SCHED;
            PG8_LDA(At, 0, 1); PG8_STAGE(PG8_SB(0, 0), b2, voffB, rsB); PG8_STAGE(PG8_SB(0, 1), b2 + hstepB, voffB, rsB); PG8_STAGE(PG8_SA(0, 0), a2, voffA, rsA);
            PG8_WAIT_V(8); PG8_WAIT_L(0); PG8_BAR; PG8_MMA(1, 0, At, B0); PG8_MMA(1, 1, At, B1); PG8_BAR; PG8_SCHED;
            PG8_LDB(B0, 1, 0); PG8_LDB(B1, 1, 1); PG8_SCHED; PG8_LDA(At, 1, 0); PG8_STAGE(PG8_SA(0, 1), a2 + hstepA, voffA, rsA);
            PG8_WAIT_V(8); PG8_WAIT_L(0); PG8_BAR; PG8_MMA(0, 0, At, B0); PG8_MMA(0, 1, At, B1); PG8_BAR; PG8_SCHED;
            PG8_LDA(At, 1, 1); PG8_STAGE(PG8_SB(1, 0), b3, voffB, rsB); PG8_STAGE(PG8_SB(1, 1), b3 + hstepB, voffB, rsB); PG8_STAGE(PG8_SA(1, 0), a3, voffA, rsA);
            PG8_WAIT_V(8); PG8_WAIT_L(0); PG8_BAR; PG8_MMA(1, 0, At, B0); PG8_MMA(1, 1, At, B1); PG8_BAR; PG8_SCHED;
            } else {
            PG8_LDB(B0, 0, 0); PG8_SCHED; PG8_LDA(At, 0, 0); PG8_STAGE(PG8_SA(1, 1), a1 + hstepA, voffA, rsA);
            PG8_WAIT_L(8); PG8_BAR; PG8_WAIT_L(0); PG8_MMA(0, 0, At, B0); PG8_BAR; PG8_SCHED;
            PG8_LDB(B1, 0, 1); PG8_STAGE(PG8_SB(0, 0), b2, voffB, rsB);
            PG8_BAR; PG8_WAIT_L(0); PG8_MMA(0, 1, At, B1); PG8_BAR;
            PG8_LDA(At, 0, 1); PG8_STAGE(PG8_SA(0, 0), a2, voffA, rsA);
            PG8_BAR; PG8_WAIT_L(0); PG8_MMA(1, 0, At, B0); PG8_BAR; PG8_SCHED;
            PG8_STAGE(PG8_SB(0, 1), b2 + hstepB, voffB, rsB);
            PG8_WAIT_V(6); PG8_BAR; PG8_MMA(1, 1, At, B1); PG8_BAR;
            PG8_LDB(B0, 1, 0); PG8_SCHED; PG8_LDA(At, 1, 0); PG8_STAGE(PG8_SA(0, 1), a2 + hstepA, voffA, rsA);
            PG8_WAIT_L(8); PG8_BAR; PG8_WAIT_L(0); PG8_MMA(0, 0, At, B0); PG8_BAR; PG8_SCHED;
            PG8_LDB(B1, 1, 1); PG8_STAGE(PG8_SB(1, 0), b3, voffB, rsB);
            PG8_BAR; PG8_WAIT_L(0); PG8_MMA(0, 1, At, B1); PG8_BAR;
            PG8_LDA(At, 1, 1); PG8_STAGE(PG8_SA(1, 0), a3, voffA, rsA);
            PG8_BAR; PG8_WAIT_L(0); PG8_MMA(1, 0, At, B0); PG8_BAR; PG8_SCHED;
            PG8_STAGE(PG8_SB(1, 1), b3 + hstepB, voffB, rsB);
            PG8_WAIT_V(6); PG8_BAR; PG8_MMA(1, 1, At, B1); PG8_BAR;
            }
        }
        if constexpr (ALIGN_EPI) { if (wr == 0) PG8_BAR; }
        { const int l_e = lane_now(); const int fr_e = l_e & 15, fq_e = l_e >> 4;
          E(acc, cur, wr, wc, fr_e, fq_e); } S.done(cur);
        if (!has_next) break;
#pragma unroll
        for (int a = 0; a < 2; ++a)
#pragma unroll
            for (int b = 0; b < 2; ++b)
#pragma unroll
                for (int m = 0; m < 4; ++m)
#pragma unroll
                    for (int n = 0; n < 2; ++n) acc[a][b][m][n] = (f32x4){0.f, 0.f, 0.f, 0.f};
        cur = nxt; cA = nA; cB = nB; ++ui; nt = cur.nk < 0 ? nt_full : cur.nk;
        if constexpr (ALIGN_EPI) { if (wr == 1) PG8_BAR; }
    }
    PG8_WAIT_V(0);
    if constexpr (!ALIGN_EPI) { if (wr == 0) PG8_BAR; }
    PG8_BAR;
#undef PG8_UA
#undef PG8_UB
#undef PG8_SA
#undef PG8_SB
#undef PG8_STAGE
#undef PG8_LDA
#undef PG8_LDB
#undef PG8_MMA
#undef PG8_CAT
#undef PG8_WAIT_V
#undef PG8_WAIT_L
#undef PG8_BAR
#undef PG8_SCHED
}
}

#ifndef PG8_SP2
#define PG8_SP2 true
#endif
#ifndef PG8_ALIGN
#define PG8_ALIGN true
#endif

constexpr int NWAVES = 8;
constexpr int DM = 4096, DFF = 11008, PW = 2048, LW = 4096, INW = 10240, NGATE = 8192;
constexpr int NBP = 4, TP = 2064, NBS = 8, TS = 32, NMETA = 16, SEQ = 2048;
constexpr int MPROMPT = NBP * TP;
constexpr int MREAL = MPROMPT + NBS * TS;
constexpr int MPAD = 8704;
constexpr float ALPHA = 1.189207115002721f;
constexpr float LN_EPS = 1e-5f;
constexpr int NPHASE = 15;
constexpr size_t O_YP = 0, O_YS = 33554432, O_PP = 34603008, O_CP = 34725888, O_LP = 34775040, O_PS = 34791424, O_CS = 35037184, O_LS = 35135488, O_END = 35168256;

constexpr size_t MiB = 1u << 20;
constexpr size_t WS_CTL = 0, CTL_ZERO_BYTES = 1024 * 1024;
constexpr size_t WS_CMAX1 = 256 * 1024, WS_CMAX2 = 384 * 1024, WS_CMAXG = 512 * 1024;
constexpr size_t WS_CMAXZ = 896 * 1024;
constexpr size_t WS_RS0 = 640 * 1024, WS_RS1 = 704 * 1024, WS_RS2 = 768 * 1024;
constexpr size_t WS_WMIX = 1 * MiB, WS_WPOOL = 145 * MiB, WS_WLRU = 147 * MiB, WS_WUPP = 151 * MiB, WS_WUPL = 167 * MiB, WS_WOUT = 199 * MiB;
constexpr size_t WS_WFA = 231 * MiB, WS_WFB = 403 * MiB;
constexpr size_t WS_XB = 489 * MiB;
constexpr size_t WS_H = 557 * MiB;
constexpr size_t WS_A = WS_H, WS_D = WS_H + 136 * MiB;
constexpr size_t WS_V = 740 * MiB;
constexpr size_t WS_MP = WS_V;
constexpr size_t WS_X1F = 876 * MiB;
constexpr size_t WS_BX = 1012 * MiB, WS_X2F = WS_BX, WS_WZB = WS_BX;
constexpr size_t WS_Z = 1148 * MiB, WS_MB = WS_Z;
constexpr size_t WS_GATES = 1318 * MiB;
constexpr size_t WS_YA = 1454 * MiB, WS_YB = 1488 * MiB;
constexpr size_t WS_CV = 1556 * MiB;
constexpr size_t WS_END = 1557 * MiB;
static_assert(WS_D + (size_t)MPAD * PW * 2 <= WS_V && WS_H + (size_t)MPAD * DFF * 2 <= WS_V, "ws map");

constexpr int CW_TMO = 0, CW_CODE = 1;
constexpr int CW_BAR = 4096;

constexpr int RING_OFF = 0, RING_BYTES = 131072;
constexpr int LDSCTL_OFF = RING_BYTES, MISC_OFF = LDSCTL_OFF + 320;
constexpr int LDS_BYTES = 147456;

#define GAS __attribute__((address_space(1)))
#define LAS __attribute__((address_space(3)))
typedef unsigned short bf16;
typedef unsigned v4u __attribute__((ext_vector_type(4)));
typedef unsigned v2u __attribute__((ext_vector_type(2)));
typedef float f32x4 __attribute__((ext_vector_type(4)));
typedef int i32x4_t __attribute__((ext_vector_type(4)));
typedef GAS unsigned gu32;
#define RLX_AGENT __ATOMIC_RELAXED, __HIP_MEMORY_SCOPE_AGENT
#define LDS_WAIT() asm volatile("s_waitcnt lgkmcnt(0)" ::: "memory")
#define VM_WAIT() asm volatile("s_waitcnt vmcnt(0)" ::: "memory")
__device__ __forceinline__ unsigned f2bf(float f) { unsigned u = __builtin_bit_cast(unsigned, f); return (u + 0x7fffu + ((u >> 16) & 1u)) >> 16; }
__device__ __forceinline__ unsigned pk2(float lo, float hi) { return f2bf(lo) | (f2bf(hi) << 16); }
__device__ __forceinline__ float bflo(unsigned w) { return __builtin_bit_cast(float, w << 16); }
__device__ __forceinline__ float bfhi(unsigned w) { return __builtin_bit_cast(float, w & 0xffff0000u); }
#define PK8(a, b, old, hi) __builtin_amdgcn_cvt_pk_fp8_f32(__builtin_amdgcn_fmed3f((a), -448.f, 448.f), __builtin_amdgcn_fmed3f((b), -448.f, 448.f), (old), (hi))
__device__ __forceinline__ float sigm(float x) { return __builtin_amdgcn_rcpf(1.0f + __expf(-x)); }
__device__ __forceinline__ int q8i(float x) { return (int)__builtin_rintf(x); }
__device__ __forceinline__ unsigned pack4(int a, int b, int c, int d) { return (unsigned)(a & 255) | ((unsigned)(b & 255) << 8) | ((unsigned)(c & 255) << 16) | ((unsigned)d << 24); }
__device__ __forceinline__ float inv127(unsigned mbits) { const float m = __builtin_bit_cast(float, mbits); return m > 0.f ? 127.f / m : 0.f; }
__device__ __forceinline__ float gelu_tanh(float x) { const float t = 1.5957691216057308f * (x + 0.044715f * x * x * x); return x * sigm(t); }

#define XB_TMO      128
#define XB_XCNT(j)  (256  + 64 * (j))
#define XB_XSUB(j)  (1280 + 64 * (j))
#define XB_XGEN(j)  (2304 + 64 * (j))
#define XB_TOP      3328
#define XB_TOPGEN   3392
#define XCD_BAR_WORDS 3456
#define XB_SPIN_CAP (1u << 18)

__device__ __forceinline__ unsigned xb_ld(unsigned* p)              { return __hip_atomic_load(p, __ATOMIC_RELAXED, __HIP_MEMORY_SCOPE_AGENT); }
__device__ __forceinline__ unsigned xb_add(unsigned* p, unsigned v) { return __hip_atomic_fetch_add(p, v, __ATOMIC_RELAXED, __HIP_MEMORY_SCOPE_AGENT); }
__device__ __forceinline__ unsigned xb_xcc_id() { return (unsigned)__builtin_amdgcn_s_getreg((3 << 11) | 20) & 0xFu; }
#define XB_SPIN(cond, bar) do { unsigned _sp = 0; while (cond) { __builtin_amdgcn_s_sleep(1); \
    if ((++_sp & 255u) == 0u) { if (xb_ld(&(bar)[XB_TMO])) break; if (_sp > XB_SPIN_CAP) { atomicAdd(&(bar)[XB_TMO], 1u); break; } } } } while (0)

struct XcdBarrier {
    unsigned* bar; unsigned x;
    volatile LAS unsigned* st;
};
__device__ __forceinline__ XcdBarrier xcd_barrier_post(unsigned* bar, volatile LAS unsigned* st, bool t0  ) {
    XcdBarrier b; b.bar = bar; b.x = xb_xcc_id(); b.st = st;
    if (t0) (void)xb_add(&bar[XB_XCNT(b.x)], 1u);
    return b;
}
__device__ __forceinline__ void xcd_barrier_complete(unsigned* bar, unsigned x, unsigned& nloc, unsigned& nx) {
    const unsigned G = gridDim.x * gridDim.y * gridDim.z;
    unsigned sum, cnt, mine, sp = 0u;
    for (;;) {
        sum = 0u; cnt = 0u; mine = 0u;
#pragma unroll
        for (unsigned j = 0; j < 16; ++j) { const unsigned c = xb_ld(&bar[XB_XCNT(j)]); sum += c; cnt += (c > 0u) ? 1u : 0u; mine = (j == x) ? c : mine; }
        if (sum == G) break;
        __builtin_amdgcn_s_sleep(1);
        if ((++sp & 255u) == 0u) { if (xb_ld(&bar[XB_TMO])) break; if (sp > XB_SPIN_CAP) { atomicAdd(&bar[XB_TMO], 1u); break; } }
    }
    nloc = mine > 0u ? mine : 1u; nx = cnt > 0u ? cnt : 1u;
}
__device__ __forceinline__ void xcd_barrier(const XcdBarrier& b, bool t0  ) {
    asm volatile("s_waitcnt vmcnt(0)" ::: "memory");
    __syncthreads();
    if (t0) {
        unsigned* bar = b.bar;
        __builtin_amdgcn_s_waitcnt(0);
        unsigned nloc = b.st[0], nx = b.st[1];
        if (nloc == 0u) { xcd_barrier_complete(bar, b.x, nloc, nx); b.st[0] = nloc; b.st[1] = nx; }
        const unsigned old = xb_add(&bar[XB_XSUB(b.x)], 1u);
        const unsigned gen = old / nloc;
        if (old + 1u == (gen + 1u) * nloc) {
            __builtin_amdgcn_fence(__ATOMIC_RELEASE, "agent");
            asm volatile("s_waitcnt vmcnt(0)" ::: "memory");
            const unsigned og = xb_add(&bar[XB_TOP], 1u);
            const unsigned tg = og / nx;
            if (og + 1u == (tg + 1u) * nx) xb_add(&bar[XB_TOPGEN], 1u);
            else XB_SPIN(xb_ld(&bar[XB_TOPGEN]) == tg, bar);
            __builtin_amdgcn_fence(__ATOMIC_ACQUIRE, "agent");
            xb_add(&bar[XB_XGEN(b.x)], 1u);
            asm volatile("s_waitcnt vmcnt(0)" ::: "memory");
        } else {
            XB_SPIN(xb_ld(&bar[XB_XGEN(b.x)]) == gen, bar);
            __builtin_amdgcn_fence(__ATOMIC_ACQUIRE, "agent");
            asm volatile("s_waitcnt vmcnt(0)" ::: "memory");
        }
    }
    __syncthreads();
}

#define WDPP(x, ctrl) __builtin_bit_cast(float, __builtin_amdgcn_update_dpp(0, __builtin_bit_cast(int, (x)), (ctrl), 0xf, 0xf, false))
__device__ __forceinline__ float wave_sum(float v) {
    v += WDPP(v, 0xB1); v += WDPP(v, 0x4E); v += WDPP(v, 0x141); v += WDPP(v, 0x140);
    v += __shfl_xor(v, 16); v += __shfl_xor(v, 32);
    return v;
}
__device__ __forceinline__ float wave_max(float v) {
    v = fmaxf(v, WDPP(v, 0xB1)); v = fmaxf(v, WDPP(v, 0x4E)); v = fmaxf(v, WDPP(v, 0x141)); v = fmaxf(v, WDPP(v, 0x140));
    v = fmaxf(v, __shfl_xor(v, 16)); v = fmaxf(v, __shfl_xor(v, 32));
    return v;
}
__device__ __forceinline__ const float* x0_row(const float* xp, const float* xs, const float* meta, int row) {
    if (row < MPROMPT) { const int b = row / TP, t = row - b * TP; return t < NMETA ? meta + (size_t)t * DM : xp + ((size_t)b * SEQ + (t - NMETA)) * DM; }
    if (row < MREAL) return xs + (size_t)(row - MPROMPT) * DM;
    return nullptr;
}

__device__ __forceinline__ void tr_item(const float* W, int ldw, bf16* WT, int ldwt, int k0, int n0, int drow0, LAS unsigned* scr, int lane) {
    const int r = lane >> 4, c = lane & 15;
    const float* src = W + (size_t)(k0 + 2 * r) * ldw + n0 + 4 * c;
    f32x4 lo[8], hi[8];
#pragma unroll
    for (int j = 0; j < 8; ++j) { lo[j] = __builtin_nontemporal_load((const f32x4*)(src + (size_t)(8 * j) * ldw)); hi[j] = __builtin_nontemporal_load((const f32x4*)(src + (size_t)(8 * j + 1) * ldw)); }
#pragma unroll
    for (int j = 0; j < 8; ++j)
#pragma unroll
        for (int e = 0; e < 4; ++e) scr[(4 * c + e) * 32 + ((j ^ (c & 7)) * 4) + r] = pg8::cvt_pk_bf16(lo[j][e], hi[j][e]);
    LDS_WAIT(); asm volatile("" ::: "memory");
    const int q = lane & 7;
#pragma unroll
    for (int i = 0; i < 8; ++i) { const int n = (lane >> 3) + 8 * i; const v4u o = *(const LAS v4u*)(scr + n * 32 + ((q ^ ((n >> 2) & 7)) * 4));
        *(GAS v4u*)(WT + (size_t)(drow0 + n) * ldwt + k0 + 8 * q) = o; }
    LDS_WAIT(); asm volatile("" ::: "memory");
}
__device__ __forceinline__ void tr_item8(const float* W, int ldw, unsigned char* WT, int pitchB, int k0, int n0, int drow0, LAS unsigned* scr, int lane, float sc) {
    const int r = lane >> 4, c = lane & 15;
    const float* src = W + (size_t)(k0 + 4 * r) * ldw + n0 + 4 * c;
    f32x4 v[8][4];
#pragma unroll
    for (int j = 0; j < 8; ++j)
#pragma unroll
        for (int i = 0; i < 4; ++i) v[j][i] = __builtin_nontemporal_load((const f32x4*)(src + (size_t)(16 * j + i) * ldw));
#pragma unroll
    for (int j = 0; j < 8; ++j)
#pragma unroll
        for (int e = 0; e < 4; ++e) { int w = PK8(v[j][0][e] * sc, v[j][1][e] * sc, 0, false); w = PK8(v[j][2][e] * sc, v[j][3][e] * sc, w, true);
            scr[(4 * c + e) * 32 + ((j ^ (c & 7)) * 4) + r] = (unsigned)w; }
    LDS_WAIT(); asm volatile("" ::: "memory");
    const int q = lane & 7;
#pragma unroll
    for (int i = 0; i < 8; ++i) { const int n = (lane >> 3) + 8 * i; const v4u o = *(const LAS v4u*)(scr + n * 32 + ((q ^ ((n >> 2) & 7)) * 4));
        *(GAS v4u*)(WT + (size_t)(drow0 + n) * pitchB + k0 + 16 * q) = o; }
    LDS_WAIT(); asm volatile("" ::: "memory");
}
__device__ __forceinline__ void tr_job(const float* W, int K, int N, bf16* WT, int mode, int roff, int it, LAS unsigned* scr, int lane) {
    const int nblk = N / 64, kb = it / nblk, nb = it - kb * nblk, k0 = 64 * kb, n0 = 64 * nb;
    int drow0;
    if (mode == 0) drow0 = roff + n0;
    else if (mode == 1) { const int half = N >> 1; const bool up = n0 >= half; const int nn = up ? n0 - half : n0; drow0 = (nn >> 7) * 256 + (nn & 127) + (up ? 128 : 0); }
    else drow0 = roff + (n0 >> 7) * 256 + (n0 & 127);
    tr_item(W, N, WT, K, k0, n0, drow0, scr, lane);
}


__device__ __forceinline__ void tr_item_i8(const float* W, int ldw, unsigned char* WT, int pitchB, int k0, int n0, int drow0, LAS unsigned* scr, int lane, const unsigned* cmax) {
    const int r = lane >> 4, c = lane & 15;
    const float* src = W + (size_t)(k0 + 4 * r) * ldw + n0 + 4 * c;
    f32x4 v[8][4];
#pragma unroll
    for (int j = 0; j < 8; ++j)
#pragma unroll
        for (int i = 0; i < 4; ++i) v[j][i] = __builtin_nontemporal_load((const f32x4*)(src + (size_t)(16 * j + i) * ldw));
    const v4u cm = *(const v4u*)(cmax + n0 + 4 * c);
    const float inv[4] = {inv127(cm.x), inv127(cm.y), inv127(cm.z), inv127(cm.w)};
#pragma unroll
    for (int j = 0; j < 8; ++j)
#pragma unroll
        for (int e = 0; e < 4; ++e) scr[(4 * c + e) * 32 + ((j ^ (c & 7)) * 4) + r] = pack4(q8i(v[j][0][e] * inv[e]), q8i(v[j][1][e] * inv[e]), q8i(v[j][2][e] * inv[e]), q8i(v[j][3][e] * inv[e]));
    LDS_WAIT(); asm volatile("" ::: "memory");
    const int q = lane & 7;
#pragma unroll
    for (int i = 0; i < 8; ++i) { const int n = (lane >> 3) + 8 * i; const v4u o = *(const LAS v4u*)(scr + n * 32 + ((q ^ ((n >> 2) & 7)) * 4));
        *(GAS v4u*)(WT + (size_t)(drow0 + n) * pitchB + k0 + 16 * q) = o; }
    LDS_WAIT(); asm volatile("" ::: "memory");
}
__device__ __forceinline__ void tr_job_i8(const float* W, int K, int N, unsigned char* WT, int mode, int it, LAS unsigned* scr, int lane, const unsigned* cmax) {
    const int nblk = N / 64, kb = it / nblk, nb = it - kb * nblk, k0 = 128 * kb, n0 = 64 * nb;
    int drow0 = n0;
    if (mode == 1) { const int half = N >> 1; const bool up = n0 >= half; const int nn = up ? n0 - half : n0; drow0 = (nn >> 7) * 256 + (nn & 127) + (up ? 128 : 0); }
    tr_item_i8(W, N, WT, K, k0, n0, drow0, scr, lane, cmax);
}
template <bool NT> __device__ __forceinline__ void colmax_job(const float* W, int N, unsigned* cmax, int it, int lane) {
    const int nblk = N / 256, kc = it / nblk, nb = it - kc * nblk;
    const float* src = W + (size_t)(64 * kc) * N + 256 * nb + 4 * lane;
    f32x4 m = (f32x4){0.f, 0.f, 0.f, 0.f};
#pragma unroll 1
    for (int jj = 0; jj < 64; jj += 16) { f32x4 v[16];
#pragma unroll
        for (int i = 0; i < 16; ++i) v[i] = NT ? __builtin_nontemporal_load((const f32x4*)(src + (size_t)(jj + i) * N)) : *(const f32x4*)(src + (size_t)(jj + i) * N);
#pragma unroll
        for (int i = 0; i < 16; ++i) { m.x = fmaxf(m.x, fabsf(v[i].x)); m.y = fmaxf(m.y, fabsf(v[i].y)); m.z = fmaxf(m.z, fabsf(v[i].z)); m.w = fmaxf(m.w, fabsf(v[i].w)); } }
    unsigned* p = cmax + 256 * nb + 4 * lane;
    const v4u mb = __builtin_bit_cast(v4u, m);
    (void)__hip_atomic_fetch_max(p + 0, mb.x, RLX_AGENT); (void)__hip_atomic_fetch_max(p + 1, mb.y, RLX_AGENT);
    (void)__hip_atomic_fetch_max(p + 2, mb.z, RLX_AGENT); (void)__hip_atomic_fetch_max(p + 3, mb.w, RLX_AGENT);
}

template <int NB> __device__ __forceinline__ void scan_blk1(const unsigned* ap, float& h, float& S) {
    unsigned wv[NB];
#pragma unroll
    for (int i = 0; i < NB; ++i) wv[i] = ap[(size_t)i * LW];
#pragma unroll
    for (int i = 0; i < NB; ++i) { const float la = bflo(wv[i]); h = __expf(la) * h + bfhi(wv[i]); S += la; }
}
template <int NB> __device__ __forceinline__ void scan_blk3(const unsigned* ap, const bf16* gp, bf16* yp, float& h) {
    unsigned wv[NB], gv[NB];
#pragma unroll
    for (int i = 0; i < NB; ++i) { wv[i] = ap[(size_t)i * LW]; gv[i] = gp[(size_t)i * INW]; }
#pragma unroll
    for (int i = 0; i < NB; ++i) { h = __expf(bflo(wv[i])) * h + bfhi(wv[i]); yp[(size_t)i * LW] = (bf16)f2bf(h * __builtin_bit_cast(float, gv[i] << 16)); }
}
using pg8::Unit; using pg8::BM; using pg8::HALF; using pg8::cvt_pk_bf16;
template <bool F8OUT  > struct EpiSwiglu {
    static constexpr bool PERM = true; bf16* H;
    __device__ __forceinline__ void operator()(const f32x4 (&acc)[2][2][4][2], const Unit& u, int wr, int wc, int fr, int fq) const {
        const int row0 = u.pm * BM + wr * 64 + fr, col0 = u.pn * 128 + wc * 32 + 8 * fq;
#pragma unroll
        for (int ai = 0; ai < 2; ++ai)
#pragma unroll
            for (int m = 0; m < 4; ++m) { const size_t eo = (size_t)(row0 + ai * HALF + m * 16) * DFF + col0;
                float h[8];
#pragma unroll
                for (int n = 0; n < 2; ++n)
#pragma unroll
                    for (int j = 0; j < 4; ++j) { const float g = acc[ai][0][m][n][j], up = acc[ai][1][m][n][j]; h[4 * n + j] = g * up * sigm(g); }
                if constexpr (F8OUT) {
                    int q0 = PK8(h[0] * 4.f, h[1] * 4.f, 0, false); q0 = PK8(h[2] * 4.f, h[3] * 4.f, q0, true);
                    int q1 = PK8(h[4] * 4.f, h[5] * 4.f, 0, false); q1 = PK8(h[6] * 4.f, h[7] * 4.f, q1, true);
                    v2u qq; qq.x = (unsigned)q0; qq.y = (unsigned)q1; *(v2u*)((unsigned char*)H + eo) = qq;
                } else {
                    v4u w; w.x = cvt_pk_bf16(h[0], h[1]); w.y = cvt_pk_bf16(h[2], h[3]); w.z = cvt_pk_bf16(h[4], h[5]); w.w = cvt_pk_bf16(h[6], h[7]);
                    *(v4u*)(H + eo) = w; } }
    }
};
struct EpiSwigluI8 {
    static constexpr bool PERM = true; unsigned char* H; const float* rs; const unsigned* cmax;
    __device__ __forceinline__ void operator()(const f32x4 (&acc)[2][2][4][2], const Unit& u, int wr, int wc, int fr, int fq) const {
        const int row0 = u.pm * BM + wr * 64 + fr, col0 = u.pn * 128 + wc * 32 + 8 * fq;
        float cg[8], cu[8];
        { const v4u a0 = *(const v4u*)(cmax + col0), a1 = *(const v4u*)(cmax + col0 + 4), b0 = *(const v4u*)(cmax + DFF + col0), b1 = *(const v4u*)(cmax + DFF + col0 + 4);
          const unsigned ga[8] = {a0.x, a0.y, a0.z, a0.w, a1.x, a1.y, a1.z, a1.w}, ua[8] = {b0.x, b0.y, b0.z, b0.w, b1.x, b1.y, b1.z, b1.w};
#pragma unroll
          for (int i = 0; i < 8; ++i) { cg[i] = __builtin_bit_cast(float, ga[i]) * (1.f / 127.f); cu[i] = __builtin_bit_cast(float, ua[i]) * (4.f / 127.f); } }
        float rsv[8];
#pragma unroll
        for (int q = 0; q < 8; ++q) rsv[q] = rs[row0 + (q >> 2) * HALF + (q & 3) * 16];
#pragma unroll
        for (int ai = 0; ai < 2; ++ai)
#pragma unroll
            for (int m = 0; m < 4; ++m) { const int row = row0 + ai * HALF + m * 16; const size_t eo = (size_t)row * DFF + col0;
                const float r = rsv[ai * 4 + m];
                float h[8];
#pragma unroll
                for (int n = 0; n < 2; ++n) { const f32x4 gv = __builtin_convertvector(__builtin_bit_cast(i32x4_t, acc[ai][0][m][n]), f32x4), uv = __builtin_convertvector(__builtin_bit_cast(i32x4_t, acc[ai][1][m][n]), f32x4);
#pragma unroll
                    for (int j = 0; j < 4; ++j) { const float g = gv[j] * (r * cg[4 * n + j]), up = uv[j] * (r * cu[4 * n + j]);
                        h[4 * n + j] = g * up * sigm(g); } }
                int q0 = PK8(h[0], h[1], 0, false); q0 = PK8(h[2], h[3], q0, true);
                int q1 = PK8(h[4], h[5], 0, false); q1 = PK8(h[6], h[7], q1, true);
                v2u qq; qq.x = (unsigned)q0; qq.y = (unsigned)q1; *(v2u*)(H + eo) = qq;
                __builtin_amdgcn_sched_barrier(0); }
    }
};
template <int MODE  > struct EpiResid {
    static constexpr bool PERM = true; bf16* V; const bf16* R; const float* xp; const float* xs; const float* meta; float scale; float* slab;
    __device__ __forceinline__ void operator()(const f32x4 (&acc)[2][2][4][2], const Unit& u, int wr, int wc, int fr, int fq) const {
        if (u.slab >= 0) {
            float* sp = slab + (size_t)u.slab * 65536 + (size_t)(wr * 64 + fr) * 256 + wc * 32 + 8 * fq;
#pragma unroll
            for (int ai = 0; ai < 2; ++ai)
#pragma unroll
                for (int m = 0; m < 4; ++m)
#pragma unroll
                    for (int bj = 0; bj < 2; ++bj) { float* q = sp + (ai * HALF + m * 16) * 256 + bj * HALF; *(f32x4*)q = acc[ai][bj][m][0]; *(f32x4*)(q + 4) = acc[ai][bj][m][1]; }
            return;
        }
        const int row0 = u.pm * BM + wr * 64 + fr, col0 = u.pn * BM + wc * 32 + 8 * fq;
#pragma unroll
        for (int ai = 0; ai < 2; ++ai) {
            v4u rw[4][2]; f32x4 rf[4][2][2]; float mk[4];
#pragma unroll
            for (int m = 0; m < 4; ++m) { const int row = row0 + ai * HALF + m * 16; mk[m] = ALPHA;
                if (MODE == 1) {
#pragma unroll
                    for (int bj = 0; bj < 2; ++bj) rw[m][bj] = *(const v4u*)(R + (size_t)row * DM + col0 + bj * HALF);
                } else { const float* rp = x0_row(xp, xs, meta, row); const float* rq = rp ? rp : xp;
                    mk[m] = rp ? ALPHA : 0.f;
#pragma unroll
                    for (int bj = 0; bj < 2; ++bj) { rf[m][bj][0] = *(const f32x4*)(rq + col0 + bj * HALF); rf[m][bj][1] = *(const f32x4*)(rq + col0 + bj * HALF + 4); } } }
            __builtin_amdgcn_sched_barrier(0);
#pragma unroll
            for (int m = 0; m < 4; ++m) { const int row = row0 + ai * HALF + m * 16;
#pragma unroll
                for (int bj = 0; bj < 2; ++bj) { const size_t o = (size_t)row * DM + col0 + bj * HALF;
                    f32x4 r0, r1;
                    if (MODE == 1) { const v4u w = rw[m][bj]; r0 = (f32x4){bflo(w.x), bfhi(w.x), bflo(w.y), bfhi(w.y)}; r1 = (f32x4){bflo(w.z), bfhi(w.z), bflo(w.w), bfhi(w.w)}; }
                    else { r0 = rf[m][bj][0]; r1 = rf[m][bj][1]; }
                    const f32x4 v0 = r0 * mk[m] + acc[ai][bj][m][0] * scale, v1 = r1 * mk[m] + acc[ai][bj][m][1] * scale;
                    v4u w; w.x = cvt_pk_bf16(v0[0], v0[1]); w.y = cvt_pk_bf16(v0[2], v0[3]); w.z = cvt_pk_bf16(v1[0], v1[1]); w.w = cvt_pk_bf16(v1[2], v1[3]);
                    *(v4u*)(V + o) = w; } }
            __builtin_amdgcn_sched_barrier(0); }
    }
};
template <bool I8> struct EpiZ {
    static constexpr bool PERM = true; bf16* Z; const float* rs; const unsigned* cmax;
    __device__ __forceinline__ void operator()(const f32x4 (&acc)[2][2][4][2], const Unit& u, int wr, int wc, int fr, int fq) const {
        const int row0 = u.pm * BM + wr * 64 + fr, col0 = u.pn * BM + wc * 32 + 8 * fq; const bool gl = u.pn >= 24;
        float rsv[8]; f32x4 cs[2][2];
        if constexpr (I8) {
#pragma unroll
            for (int q = 0; q < 8; ++q) rsv[q] = rs[row0 + (q >> 2) * HALF + (q & 3) * 16] * (1.f / 127.f);
#pragma unroll
            for (int bj = 0; bj < 2; ++bj) { cs[bj][0] = __builtin_bit_cast(f32x4, *(const v4u*)(cmax + col0 + bj * HALF)); cs[bj][1] = __builtin_bit_cast(f32x4, *(const v4u*)(cmax + col0 + bj * HALF + 4)); } }
#pragma unroll
        for (int ai = 0; ai < 2; ++ai)
#pragma unroll
            for (int m = 0; m < 4; ++m) { bf16* rowp = Z + (size_t)(row0 + ai * HALF + m * 16) * INW + col0;
#pragma unroll
                for (int bj = 0; bj < 2; ++bj) { f32x4 v0 = acc[ai][bj][m][0], v1 = acc[ai][bj][m][1];
                    if constexpr (I8) { const float r = rsv[ai * 4 + m];
                        v0 = __builtin_convertvector(__builtin_bit_cast(i32x4_t, acc[ai][bj][m][0]), f32x4) * (cs[bj][0] * r); v1 = __builtin_convertvector(__builtin_bit_cast(i32x4_t, acc[ai][bj][m][1]), f32x4) * (cs[bj][1] * r); }
                    if (gl) {
#pragma unroll
                        for (int j = 0; j < 4; ++j) { v0[j] = gelu_tanh(v0[j]); v1[j] = gelu_tanh(v1[j]); } }
                    v4u w; w.x = cvt_pk_bf16(v0[0], v0[1]); w.y = cvt_pk_bf16(v0[2], v0[3]); w.z = cvt_pk_bf16(v1[0], v1[1]); w.w = cvt_pk_bf16(v1[2], v1[3]);
                    *(v4u*)(rowp + bj * HALF) = w; } }
    }
};
struct EpiGate {
    static constexpr bool PERM = true; bf16* Gt; const float* bg; const float* rs; const unsigned* cmax;
    __device__ __forceinline__ void operator()(const f32x4 (&acc)[2][2][4][2], const Unit& u, int wr, int wc, int fr, int fq) const {
        const int row0 = u.pm * BM + wr * 64 + fr, col0 = u.pn * BM + wc * 32 + 8 * fq;
        float rsv[8]; f32x4 cs[2][2], bs[2][2];
#pragma unroll
        for (int q = 0; q < 8; ++q) rsv[q] = rs[row0 + (q >> 2) * HALF + (q & 3) * 16];
#pragma unroll
        for (int bj = 0; bj < 2; ++bj) { cs[bj][0] = __builtin_bit_cast(f32x4, *(const v4u*)(cmax + col0 + bj * HALF)); cs[bj][1] = __builtin_bit_cast(f32x4, *(const v4u*)(cmax + col0 + bj * HALF + 4));
            bs[bj][0] = *(const f32x4*)(bg + col0 + bj * HALF); bs[bj][1] = *(const f32x4*)(bg + col0 + bj * HALF + 4); }
        __builtin_amdgcn_sched_barrier(0);
#pragma unroll
        for (int bj = 0; bj < 2; ++bj) { cs[bj][0] = cs[bj][0] * (1.f / 127.f); cs[bj][1] = cs[bj][1] * (1.f / 127.f); }
#pragma unroll
        for (int ai = 0; ai < 2; ++ai)
#pragma unroll
            for (int m = 0; m < 4; ++m) { bf16* rowp = Gt + (size_t)(row0 + ai * HALF + m * 16) * NGATE + col0; const float r = rsv[ai * 4 + m];
#pragma unroll
                for (int bj = 0; bj < 2; ++bj) {
                    const i32x4_t i0 = __builtin_bit_cast(i32x4_t, acc[ai][bj][m][0]), i1 = __builtin_bit_cast(i32x4_t, acc[ai][bj][m][1]);
                    f32x4 v0 = __builtin_convertvector(i0, f32x4) * (cs[bj][0] * r) + bs[bj][0], v1 = __builtin_convertvector(i1, f32x4) * (cs[bj][1] * r) + bs[bj][1];
#pragma unroll
                    for (int j = 0; j < 4; ++j) { v0[j] = sigm(v0[j]); v1[j] = sigm(v1[j]); }
                    v4u w; w.x = cvt_pk_bf16(v0[0], v0[1]); w.y = cvt_pk_bf16(v0[2], v0[3]); w.z = cvt_pk_bf16(v1[0], v1[1]); w.w = cvt_pk_bf16(v1[2], v1[3]);
                    *(v4u*)(rowp + bj * HALF) = w; }
                __builtin_amdgcn_sched_barrier(0); }
    }
};
struct EpiPool {
    static constexpr bool PERM = true; bf16* YA; const float* ps;
    __device__ __forceinline__ void operator()(const f32x4 (&acc)[2][2][4][2], const Unit& u, int wr, int wc, int fr, int fq) const {
        const int row0 = u.pm * BM + wr * 64 + fr, col0 = u.pn * BM + wc * 32 + 8 * fq;
        f32x4 sv[2][2];
#pragma unroll
        for (int bj = 0; bj < 2; ++bj)
#pragma unroll
            for (int n = 0; n < 2; ++n) sv[bj][n] = *(const f32x4*)(ps + col0 + bj * HALF + 4 * n);
#pragma unroll
        for (int ai = 0; ai < 2; ++ai)
#pragma unroll
            for (int m = 0; m < 4; ++m) { bf16* rowp = YA + (size_t)(row0 + ai * HALF + m * 16) * PW + col0;
#pragma unroll
                for (int bj = 0; bj < 2; ++bj) { const f32x4 v0 = acc[ai][bj][m][0] * sv[bj][0], v1 = acc[ai][bj][m][1] * sv[bj][1];
                    v4u w; w.x = cvt_pk_bf16(v0[0], v0[1]); w.y = cvt_pk_bf16(v0[2], v0[3]); w.z = cvt_pk_bf16(v1[0], v1[1]); w.w = cvt_pk_bf16(v1[2], v1[3]);
                    *(v4u*)(rowp + bj * HALF) = w; } }
    }
};
struct EpiLru {
    static constexpr bool PERM = true; unsigned* AB; const bf16* XC; const float* ba; const float* bxb; const float* cvp;
    __device__ __forceinline__ void operator()(const f32x4 (&acc)[2][2][4][2], const Unit& u, int wr, int wc, int fr, int fq) const {
        const int row0 = u.pm * BM + wr * 64 + fr, ch0 = u.pn * 128 + wc * 32 + 8 * fq;
        f32x4 bav[2], bxv[2], cv[2];
#pragma unroll
        for (int n = 0; n < 2; ++n) { bav[n] = *(const f32x4*)(ba + ch0 + 4 * n); bxv[n] = *(const f32x4*)(bxb + ch0 + 4 * n); cv[n] = *(const f32x4*)(cvp + ch0 + 4 * n); }
        v4u xwv[8];
#pragma unroll
        for (int q = 0; q < 8; ++q) xwv[q] = *(const v4u*)(XC + (size_t)(row0 + (q >> 2) * HALF + (q & 3) * 16) * LW + ch0);
        __builtin_amdgcn_sched_barrier(0);
#pragma unroll
        for (int ai = 0; ai < 2; ++ai)
#pragma unroll
            for (int m = 0; m < 4; ++m) { const size_t ro = (size_t)(row0 + ai * HALF + m * 16) * LW + ch0;
                const v4u xw = xwv[ai * 4 + m];
#pragma unroll
                for (int n = 0; n < 2; ++n) { const unsigned w0 = n ? xw.z : xw.x, w1 = n ? xw.w : xw.y;
                    const f32x4 xv = (f32x4){bflo(w0), bfhi(w0), bflo(w1), bfhi(w1)};
                    v4u pw;
#pragma unroll
                    for (int j = 0; j < 4; ++j) { const float r = sigm(acc[ai][0][m][n][j] + bav[n][j]), ig = sigm(acc[ai][1][m][n][j] + bxv[n][j]);
                        const float la = cv[n][j] * r, a = __expf(la), om = 1.0f - a * a;
                        pw[j] = cvt_pk_bf16(la, sqrtf(fmaxf(om, 0.0f)) * (ig * xv[j])); }
                    *(v4u*)(AB + ro + 4 * n) = pw; }
                __builtin_amdgcn_sched_barrier(0); }
    }
};
struct EpiUpPool {
    static constexpr bool PERM = true; bf16* MP; const bf16* Gt; float* slab;
    __device__ __forceinline__ void operator()(const f32x4 (&acc)[2][2][4][2], const Unit& u, int wr, int wc, int fr, int fq) const {
        const int row0 = u.pm * BM + wr * 64 + fr, col0 = u.pn * BM + wc * 32 + 8 * fq;
        float* sp = slab + (size_t)(u.slab >= 0 ? u.slab : 0) * 65536 + (size_t)(wr * 64 + fr) * 256 + wc * 32 + 8 * fq;
#pragma unroll
        for (int ai = 0; ai < 2; ++ai) {
            v4u gwv[4][2];
#pragma unroll
            for (int m = 0; m < 4; ++m)
#pragma unroll
                for (int bj = 0; bj < 2; ++bj) gwv[m][bj] = *(const v4u*)(Gt + (size_t)(row0 + ai * HALF + m * 16) * NGATE + col0 + bj * HALF);
            __builtin_amdgcn_sched_barrier(0);
#pragma unroll
            for (int m = 0; m < 4; ++m) { const int row = row0 + ai * HALF + m * 16;
#pragma unroll
                for (int bj = 0; bj < 2; ++bj) { const v4u gw = gwv[m][bj];
                    const f32x4 g0 = (f32x4){bflo(gw.x), bfhi(gw.x), bflo(gw.y), bfhi(gw.y)}, g1 = (f32x4){bflo(gw.z), bfhi(gw.z), bflo(gw.w), bfhi(gw.w)};
                    const f32x4 v0 = acc[ai][bj][m][0] * g0, v1 = acc[ai][bj][m][1] * g1;
                    if (u.slab >= 0) {
                        float* q = sp + (ai * HALF + m * 16) * 256 + bj * HALF; *(f32x4*)q = v0; *(f32x4*)(q + 4) = v1;
                    } else { v4u w; w.x = cvt_pk_bf16(v0[0], v0[1]); w.y = cvt_pk_bf16(v0[2], v0[3]); w.z = cvt_pk_bf16(v1[0], v1[1]); w.w = cvt_pk_bf16(v1[2], v1[3]);
                        *(v4u*)(MP + (size_t)row * DM + col0 + bj * HALF) = w; } } }
            __builtin_amdgcn_sched_barrier(0); }
    }
};
struct EpiUpLru {
    static constexpr bool PERM = true; bf16* Mb; const bf16* MP; const bf16* Gt; float* slab; const float* slab8;
    __device__ __forceinline__ void operator()(const f32x4 (&acc)[2][2][4][2], const Unit& u, int wr, int wc, int fr, int fq) const {
        const int row0 = u.pm * BM + wr * 64 + fr, col0 = u.pn * BM + wc * 32 + 8 * fq;
        if (u.slab >= 0) {
            float* sp = slab + (size_t)u.slab * 65536 + (size_t)(wr * 64 + fr) * 256 + wc * 32 + 8 * fq;
#pragma unroll
            for (int h = 0; h < 4; ++h) {
                v4u gwv[2][2]; f32x4 pv[2][2][2];
#pragma unroll
                for (int mm = 0; mm < 2; ++mm) { const int ai = h >> 1, m = 2 * (h & 1) + mm, row = row0 + ai * HALF + m * 16;
#pragma unroll
                    for (int bj = 0; bj < 2; ++bj) { gwv[mm][bj] = *(const v4u*)(Gt + (size_t)row * NGATE + DM + col0 + bj * HALF);
                        const float* q8p = slab8 + (size_t)u.slab * 65536 + (size_t)(wr * 64 + fr) * 256 + wc * 32 + 8 * fq + (ai * HALF + m * 16) * 256 + bj * HALF;
                        pv[mm][bj][0] = __builtin_nontemporal_load((const f32x4*)q8p); pv[mm][bj][1] = __builtin_nontemporal_load((const f32x4*)(q8p + 4)); } }
                __builtin_amdgcn_sched_barrier(0);
#pragma unroll
                for (int mm = 0; mm < 2; ++mm) { const int ai = h >> 1, m = 2 * (h & 1) + mm;
#pragma unroll
                    for (int bj = 0; bj < 2; ++bj) { const v4u gw = gwv[mm][bj];
                        const f32x4 g0 = (f32x4){bflo(gw.x), bfhi(gw.x), bflo(gw.y), bfhi(gw.y)}, g1 = (f32x4){bflo(gw.z), bfhi(gw.z), bflo(gw.w), bfhi(gw.w)};
                        float* q = sp + (ai * HALF + m * 16) * 256 + bj * HALF;
                        *(f32x4*)q = pv[mm][bj][0] + acc[ai][bj][m][0] * g0; *(f32x4*)(q + 4) = pv[mm][bj][1] + acc[ai][bj][m][1] * g1; } }
                __builtin_amdgcn_sched_barrier(0); }
            return;
        }
#pragma unroll
        for (int ai = 0; ai < 2; ++ai) {
            v4u gwv[4][2], mwv[4][2];
#pragma unroll
            for (int m = 0; m < 4; ++m) { const int row = row0 + ai * HALF + m * 16;
#pragma unroll
                for (int bj = 0; bj < 2; ++bj) { gwv[m][bj] = *(const v4u*)(Gt + (size_t)row * NGATE + DM + col0 + bj * HALF);
                    mwv[m][bj] = __builtin_nontemporal_load((const v4u*)(MP + (size_t)row * DM + col0 + bj * HALF)); } }
            __builtin_amdgcn_sched_barrier(0);
#pragma unroll
            for (int m = 0; m < 4; ++m) { const int row = row0 + ai * HALF + m * 16;
#pragma unroll
                for (int bj = 0; bj < 2; ++bj) { const v4u gw = gwv[m][bj], mw = mwv[m][bj];
                    const f32x4 g0 = (f32x4){bflo(gw.x), bfhi(gw.x), bflo(gw.y), bfhi(gw.y)}, g1 = (f32x4){bflo(gw.z), bfhi(gw.z), bflo(gw.w), bfhi(gw.w)};
                    const f32x4 v0 = (f32x4){bflo(mw.x), bfhi(mw.x), bflo(mw.y), bfhi(mw.y)} + acc[ai][bj][m][0] * g0, v1 = (f32x4){bflo(mw.z), bfhi(mw.z), bflo(mw.w), bfhi(mw.w)} + acc[ai][bj][m][1] * g1;
                    v4u w; w.x = cvt_pk_bf16(v0[0], v0[1]); w.y = cvt_pk_bf16(v0[2], v0[3]); w.z = cvt_pk_bf16(v1[0], v1[1]); w.w = cvt_pk_bf16(v1[2], v1[3]);
                    *(v4u*)(Mb + (size_t)row * DM + col0 + bj * HALF) = w; } }
            __builtin_amdgcn_sched_barrier(0); }
    }
};

template <int MODE, bool QC = false> __device__ __forceinline__ void ln_finish(f32x4 (&v)[16], const f32x4 (&gv)[16], const f32x4 (&bv)[16], float* dst, bf16* xbrow, unsigned char* q8row, float* rsrow, int lane) {
    float s = 0.f;
#pragma unroll
    for (int j = 0; j < 16; ++j) s += (v[j].x + v[j].y) + (v[j].z + v[j].w);
    const float mean = wave_sum(s) * (1.f / DM); float s2 = 0.f;
#pragma unroll
    for (int j = 0; j < 16; ++j) { v[j] = v[j] - mean; s2 += (v[j].x * v[j].x + v[j].y * v[j].y) + (v[j].z * v[j].z + v[j].w * v[j].w); }
    const float rstd = 1.f / sqrtf(wave_sum(s2) * (1.f / DM) + LN_EPS);
    float mx = 0.f;
#pragma unroll
    for (int c = 0; c < 8; ++c) { const int o = 8 * lane + 512 * c;
        const f32x4 y0 = v[2 * c] * rstd * gv[2 * c] + bv[2 * c], y1 = v[2 * c + 1] * rstd * gv[2 * c + 1] + bv[2 * c + 1];
        if (MODE == 1) { *(f32x4*)(dst + o) = y0; *(f32x4*)(dst + o + 4) = y1; }
        if (MODE == 0) { v4u w; w.x = pg8::cvt_pk_bf16(y0.x, y0.y); w.y = pg8::cvt_pk_bf16(y0.z, y0.w); w.z = pg8::cvt_pk_bf16(y1.x, y1.y); w.w = pg8::cvt_pk_bf16(y1.z, y1.w); *(v4u*)(xbrow + o) = w;
            if (QC) { v[2 * c] = y0; v[2 * c + 1] = y1;
                mx = fmaxf(mx, fmaxf(fmaxf(fmaxf(fabsf(y0.x), fabsf(y0.y)), fmaxf(fabsf(y0.z), fabsf(y0.w))), fmaxf(fmaxf(fabsf(y1.x), fabsf(y1.y)), fmaxf(fabsf(y1.z), fabsf(y1.w))))); } } }
    if (MODE == 0 && QC) {
        mx = wave_max(mx); const float inv = mx > 0.f ? 127.f / mx : 0.f;
        if (lane == 0) *rsrow = mx * (1.f / 127.f);
#pragma unroll
        for (int c = 0; c < 8; ++c) { const f32x4 a = v[2 * c] * inv, b = v[2 * c + 1] * inv;
            v2u qq; qq.x = pack4(q8i(a.x), q8i(a.y), q8i(a.z), q8i(a.w)); qq.y = pack4(q8i(b.x), q8i(b.y), q8i(b.z), q8i(b.w)); *(v2u*)(q8row + 8 * lane + 512 * c) = qq; }
    }
}
template <int MODE> __device__ __forceinline__ float* ln_dst(int row, float* Xf, float* out) {
    if (MODE == 1) {
        if (row < MPROMPT) { const int b = row / TP, t = row - b * TP; if (t < NMETA) return nullptr; return out + O_YP + ((size_t)b * SEQ + (t - NMETA)) * DM; }
        return out + O_YS + (size_t)(row - MPROMPT) * DM;
    }
    return Xf;
}
template <int MODE, int RES, bool QC = false> __device__ __forceinline__ void ln_rows(bf16* V, const float* slab, const bf16* resbuf, const float* xp, const float* xs, const float* meta, float scale,
                                                                     const float* gam, const float* bet, float* Xf, bf16* Xb, float* out, int gw, int NGW, int lane, unsigned char* Xq = nullptr, float* Rs = nullptr) {
    const int nrows = MODE == 0 ? MPAD : MREAL;
    const int wv = gw & (NWAVES - 1), cu = gw / NWAVES, Gq = NGW / NWAVES, TPW = (MPAD - 8192 + Gq - 1) / Gq;
    for (int k = 0; k < TPW; ++k) { const int row = 8192 + cu * TPW + k; if (row >= nrows) break;
        asm volatile("" : "+v"(lane));
        const int pmi = (row - 8192) >> 8, rr = row & 255;
        const float* rp = RES == 1 ? nullptr : x0_row(xp, xs, meta, row);
#pragma unroll
        for (int jj = 0; jj < 2; ++jj) { const int j = wv + NWAVES * jj; const float* sp = slab + ((size_t)((pmi * 16 + j) * 8) * 256 + rr) * 256 + 4 * lane;
            f32x4 a = *(const f32x4*)sp;
#pragma unroll
            for (int ks = 1; ks < 8; ++ks) a += *(const f32x4*)(sp + (size_t)ks * 65536);
            f32x4 r = (f32x4){0.f, 0.f, 0.f, 0.f};
            if (RES == 1) { const v2u w = *(const v2u*)(resbuf + (size_t)row * DM + 4 * lane + 256 * j); r = (f32x4){bflo(w.x), bfhi(w.x), bflo(w.y), bfhi(w.y)}; } else if (rp) r = *(const f32x4*)(rp + 4 * lane + 256 * j);
            const f32x4 y = r * ALPHA + a * scale; v2u w; w.x = pg8::cvt_pk_bf16(y.x, y.y); w.y = pg8::cvt_pk_bf16(y.z, y.w);
            *(v2u*)(V + (size_t)row * DM + 4 * lane + 256 * j) = w; }
    }
    asm volatile("s_waitcnt vmcnt(0)" ::: "memory");
    __syncthreads();
    f32x4 gv[16], bv[16];
#pragma unroll
    for (int c = 0; c < 8; ++c) { const int o = 8 * lane + 512 * c; gv[2 * c] = *(const f32x4*)(gam + o); gv[2 * c + 1] = *(const f32x4*)(gam + o + 4); bv[2 * c] = *(const f32x4*)(bet + o); bv[2 * c + 1] = *(const f32x4*)(bet + o + 4); }
    const int nmain = gw < 8192 ? (8192 - gw + NGW - 1) / NGW : 0, ntail = wv < TPW ? (TPW - wv + NWAVES - 1) / NWAVES : 0;
    for (int it = 0; it < nmain + ntail; ++it) {
        const int row = it < nmain ? gw + it * NGW : 8192 + cu * TPW + wv + (it - nmain) * NWAVES;
        if (row >= nrows) break;
        float* dst = ln_dst<MODE>(row, Xf, out); if (!dst) continue;
        asm volatile("" : "+v"(lane));
        f32x4 v[16];
#pragma unroll
        for (int c = 0; c < 8; ++c) { const v4u w = __builtin_nontemporal_load((const v4u*)(V + (size_t)row * DM + 8 * lane + 512 * c));
            v[2 * c] = (f32x4){bflo(w.x), bfhi(w.x), bflo(w.y), bfhi(w.y)}; v[2 * c + 1] = (f32x4){bflo(w.z), bfhi(w.z), bflo(w.w), bfhi(w.w)}; }
        ln_finish<MODE, QC>(v, gv, bv, dst, Xb + (size_t)row * DM, QC ? Xq + (size_t)row * DM : nullptr, QC ? Rs + row : nullptr, lane);
    }
}

__host__ __device__ __forceinline__ int pg8_units(int n, int G, int w) { return n > w ? (n - 1 - w) / G + 1 : 0; }
struct Args { const float* in[31]; float* out; unsigned char* ws; int ph_lo, ph_hi, li, pad; };
__global__ void __launch_bounds__(NWAVES * 64, 2) mk_fwd(Args args) {
    extern __shared__ __attribute__((aligned(16))) unsigned char lds_raw[];
    LAS unsigned char* lds = (LAS unsigned char*)lds_raw;
    volatile LAS unsigned* MISC = (volatile LAS unsigned*)(lds + MISC_OFF);
    const int wave = __builtin_amdgcn_readfirstlane((int)threadIdx.x >> 6);
#define PHASE_IDS const int lane = lane_now(), tid = (wave << 6) | lane, gtid = vcu * (NWAVES * 64) + tid; (void)tid; (void)gtid
    const int G = gridDim.x; const int bx = blockIdx.x; const int vcu = (G % 8 == 0) ? (bx % 8) * (G / 8) + bx / 8 : bx;
    unsigned char* ws = args.ws;
    gu32* ctl = (gu32*)(ws + WS_CTL);
    const float* x_prompt = args.in[0]; const float* x_sample = args.in[1]; const float* state_pool = args.in[2]; const float* state_conv = args.in[3]; const float* state_lru = args.in[4];
    const float* meta = args.in[5];
    float* out = args.out;
    bf16* WMIX = (bf16*)(ws + WS_WMIX); bf16* WPOOL = (bf16*)(ws + WS_WPOOL); bf16* WLRU = (bf16*)(ws + WS_WLRU); bf16* WUPP = (bf16*)(ws + WS_WUPP); bf16* WUPL = (bf16*)(ws + WS_WUPL); bf16* WOUT = (bf16*)(ws + WS_WOUT);
    bf16* WFA = (bf16*)(ws + WS_WFA); bf16* WFB = (bf16*)(ws + WS_WFB);
    bf16* XB = (bf16*)(ws + WS_XB); bf16* HB = (bf16*)(ws + WS_H); unsigned* ABW = (unsigned*)(ws + WS_A); bf16* DB = (bf16*)(ws + WS_D);
    bf16* VB = (bf16*)(ws + WS_V); bf16* MPB = (bf16*)(ws + WS_MP); bf16* X1B = (bf16*)(ws + WS_X1F); unsigned char* X1Q8 = ws + WS_X1F + 68 * MiB;     unsigned char* WG8 = ws + WS_WMIX + (size_t)INW * DM * 2;
    bf16* ZB = (bf16*)(ws + WS_Z); bf16* MB = (bf16*)(ws + WS_MB); bf16* GT = (bf16*)(ws + WS_GATES); bf16* YA = (bf16*)(ws + WS_YA); bf16* YB = (bf16*)(ws + WS_YB); float* CVB = (float*)(ws + WS_CV); float* SLAB2 = (float*)(ws + WS_H);
    float* SLAB = (float*)(ws + WS_GATES);
    unsigned* CMAX1 = (unsigned*)(ws + WS_CMAX1); unsigned* CMAX2 = (unsigned*)(ws + WS_CMAX2); unsigned* CMAXG = (unsigned*)(ws + WS_CMAXG); unsigned* CMAXZ = (unsigned*)(ws + WS_CMAXZ); bf16* WZB = (bf16*)(ws + WS_WZB);
    float* RS0 = (float*)(ws + WS_RS0); float* RS1 = (float*)(ws + WS_RS1); float* RS2 = (float*)(ws + WS_RS2);
    unsigned char* XQ0 = ws + WS_XB;            unsigned char* X2Q = X1Q8;

    { const int tid0 = (wave << 6) | lane_now(); for (int u = tid0; u < (LDS_BYTES - LDSCTL_OFF) / 4; u += NWAVES * 64) ((LAS unsigned*)(lds + LDSCTL_OFF))[u] = 0u; }
    __syncthreads();
    XcdBarrier bar = xcd_barrier_post((unsigned*)(ctl + CW_BAR) + args.li * XCD_BAR_WORDS, MISC + 8, wave == 0 && lane_now() == 0);
#define GRID_BAR() xcd_barrier(bar, wave == 0 && lane_now() == 0)
    const int lo = args.ph_lo, hi = args.ph_hi;
#define IN(k) (lo <= (k) && (k) < hi)
#define BOTH(k) (IN(k) && IN((k) + 1))
    const int gw = vcu * NWAVES + wave, NGW = G * NWAVES;
    const int NT = G * NWAVES * 64;
    LAS unsigned* scr = (LAS unsigned*)(lds + RING_OFF + wave * 16384);

    if (IN(0)) { PHASE_IDS;
        { constexpr int C0 = 64 * 86, C1 = 64 * 86, C2 = 64 * 32, C3 = 64 * 40;
          for (int it = gw; it < C0 + C1 + C2 + C3; it += NGW) {
              if (it < C0) colmax_job<true>(args.in[6], 2 * DFF, CMAX1, it, lane);
              else if (it < C0 + C1) colmax_job<true>(args.in[27], 2 * DFF, CMAX2, it - C0, lane);
              else if (it < C0 + C1 + C2) colmax_job<false>(args.in[20], NGATE, CMAXG, it - C0 - C1, lane);
              else colmax_job<false>(args.in[10], INW, CMAXZ, it - C0 - C1 - C2, lane); } }
        GRID_BAR();
        constexpr int I0 = 32 * 344  , I2 = 32 * 160  , I3 = 32 * 128  , I4 = 4 * 64, I5 = 16 * 16, I6 = 16 * 16, I7 = 64 * 96  ;
        constexpr int NITEMS = I0 + I2 + I3 + I4 + I5 + I6 + I7;
        for (int it = gw; it < NITEMS; it += NGW) {
            int r = it;
            if (r < I2) { tr_job_i8(args.in[10], DM, INW, (unsigned char*)WMIX, 0, r, scr, lane, CMAXZ); continue; } r -= I2;
            if (r < I7) { const int kb = r / 96, nb = r - kb * 96; tr_item(args.in[10], INW, WZB, DM, 64 * kb, 64 * nb, 64 * nb, scr, lane); continue; } r -= I7;
            if (r < I3) { tr_job_i8(args.in[20], DM, NGATE, WG8, 0, r, scr, lane, CMAXG); continue; } r -= I3;
            if (r < I0) { tr_job_i8(args.in[6], DM, 2 * DFF, (unsigned char*)WFA, 1, r, scr, lane, CMAX1); continue; } r -= I0;
            if (r < I4) { const int g = r >> 6; tr_job(args.in[11] + (size_t)g * 512 * 512, 512, 512, WPOOL, 0, g * 512, r & 63, scr, lane); continue; } r -= I4;
            if (r < I5) { const int b = r >> 4; tr_job(args.in[15] + (size_t)b * 256 * 256, 256, 256, WLRU, 2, b * 512, r & 15, scr, lane); continue; } r -= I5;
            { const int b = r >> 4; tr_job(args.in[17] + (size_t)b * 256 * 256, 256, 256, WLRU, 2, b * 512 + 128, r & 15, scr, lane); }
        }
        for (int row = gw; row < MPAD; row += NGW) {
            const float* src = x0_row(x_prompt, x_sample, meta, row);
            f32x4 a[16]; float mx = 0.f;
#pragma unroll
            for (int j = 0; j < 8; ++j) { a[2 * j] = (f32x4){0.f, 0.f, 0.f, 0.f}; a[2 * j + 1] = a[2 * j];
                if (src) { a[2 * j] = *(const f32x4*)(src + 512 * j + 8 * lane); a[2 * j + 1] = *(const f32x4*)(src + 512 * j + 8 * lane + 4); } }
#pragma unroll
            for (int j = 0; j < 16; ++j) mx = fmaxf(mx, fmaxf(fmaxf(fabsf(a[j].x), fabsf(a[j].y)), fmaxf(fabsf(a[j].z), fabsf(a[j].w))));
            mx = wave_max(mx); const float inv = mx > 0.f ? 127.f / mx : 0.f;
            if (lane == 0) RS0[row] = mx * (1.f / 127.f);
#pragma unroll
            for (int j = 0; j < 8; ++j) { const f32x4 p = a[2 * j] * inv, q = a[2 * j + 1] * inv;
                v2u w; w.x = pack4(q8i(p.x), q8i(p.y), q8i(p.z), q8i(p.w)); w.y = pack4(q8i(q.x), q8i(q.y), q8i(q.z), q8i(q.w));
                *(v2u*)(XQ0 + (size_t)row * DM + 512 * j + 8 * lane) = w; }
        }
        for (int i = gtid; i < LW; i += NT) CVB[i] = -8.0f * log1pf(expf(-args.in[19][i]));
        if (BOTH(0)) GRID_BAR();
    }
#define TAIL_WGS(nun) (((nun) % G) == 0 ? G : G - ((nun) % G))
#define TAIL_RANK(nun) (((nun) % G) == 0 ? bx : bx - ((nun) % G))
    if (IN(1)) { PHASE_IDS;
        pg8::Gemm g{(const bf16*)XQ0, WFA, DM / 2, DM / 2, DM / 2, 1 << 20, 0}; pg8::StaticOrder S; S.init(MPAD, 2 * DFF, G, bx);
        EpiSwigluI8 E{(unsigned char*)HB, RS0, CMAX1};
        pg8::gemm_phase<EpiSwigluI8, pg8::StaticOrder, PG8_ALIGN, PG8_SP2, 2>(lds + RING_OFF, g, S, E, wave);
        { const int tr = TAIL_RANK(34 * 86), tn = TAIL_WGS(34 * 86);
          if (tr >= 0) for (int it = tr * NWAVES + wave; it < 86 * 64; it += tn * NWAVES) { const int kb = it >> 6, nb = it & 63; tr_item8(args.in[7], DM, (unsigned char*)WFB, DFF, 128 * kb, 64 * nb, 64 * nb, scr, lane, 128.f); } }
        if (BOTH(1)) GRID_BAR();
    }
    if (IN(2)) { PHASE_IDS;
        pg8::Gemm g{HB, WFB, DFF / 2, DFF / 2, DFF / 2, 1 << 20, 0}; pg8::SplitTailOrder S; S.init(DM, DFF / 128, G, bx);
        EpiResid<0> E{VB, nullptr, x_prompt, x_sample, meta, 0.5f / 512.f, SLAB};
        pg8::gemm_phase<EpiResid<0>, pg8::SplitTailOrder, PG8_ALIGN, PG8_SP2, true>(lds + RING_OFF, g, S, E, wave);
        if (BOTH(2)) GRID_BAR();
    }
    if (IN(3)) { PHASE_IDS;
        ln_rows<0, 0, true>(VB, SLAB, nullptr, x_prompt, x_sample, meta, 0.5f / 512.f, args.in[8], args.in[9], out, X1B, nullptr, gw, NGW, lane, X1Q8, RS1);
        for (int it = gw; it < 32 * 344; it += NGW) tr_job_i8(args.in[27], DM, 2 * DFF, (unsigned char*)WFA, 1, it, scr, lane, CMAX2);
        if (BOTH(3)) GRID_BAR();
    }
    if (IN(4)) { PHASE_IDS;
        constexpr int NZ8 = 34 * 16 + 29 * 24, NZB = 5 * 24, NGT = 34 * 32;
        const int c8 = bx, cb = ((bx - NZ8) % G + G) % G, cg = ((bx - NZ8 - NZB) % G + G) % G;
        { pg8::Gemm g{(const bf16*)X1Q8, WMIX, DM / 2, DM / 2, DM / 2, 1 << 20, 0}; pg8::Z8Order S; S.init(G, c8);
          EpiZ<true> E{ZB, RS1, CMAXZ};
          pg8::gemm_phase<EpiZ<true>, pg8::Z8Order, PG8_ALIGN, PG8_SP2, 2>(lds + RING_OFF, g, S, E, wave); }
        { pg8::Gemm g{X1B, WZB, DM, DM, DM, 1 << 20, 0}; pg8::ZbOrder S; S.init(G, cb);
          EpiZ<false> E{ZB, nullptr, nullptr};
          pg8::gemm_phase<EpiZ<false>, pg8::ZbOrder, PG8_ALIGN, PG8_SP2>(lds + RING_OFF, g, S, E, wave); }
        { pg8::Gemm g{(const bf16*)X1Q8, (const bf16*)WG8, DM / 2, DM / 2, DM / 2, 1 << 20, 0}; pg8::StaticOrder S; S.init(MPAD, NGATE, G, cg);
          EpiGate E{GT, args.in[21], RS1, CMAXG};
          pg8::gemm_phase<EpiGate, pg8::StaticOrder, PG8_ALIGN, PG8_SP2, 2>(lds + RING_OFF, g, S, E, wave); }
        {
          const bool conv = G == 256 && bx >= 80; const int tn = G == 256 ? 248 : 0;
          const int s0 = bx < 144 ? bx - 80 : (bx < 216 ? 64 + 2 * (bx - 144) : 208 + (bx - 216)), ns = (bx >= 144 && bx < 216) ? 2 : 1;
          const int lane = lane_now();
          if (tn > 0 && conv) for (int sl = s0; sl < s0 + ns; ++sl) for (int it = sl * NWAVES + wave; it < 32 * 64 + 2 * 64 * 64; it += tn * NWAVES) {
              if (it < 32 * 64) tr_job(args.in[22], PW, DM, WUPP, 0, 0, it, scr, lane);
              else if (it < 32 * 64 + 64 * 64) tr_job(args.in[23], LW, DM, WUPL, 0, 0, it - 32 * 64, scr, lane);
              else tr_job(args.in[24], DM, DM, WOUT, 0, 0, it - 32 * 64 - 64 * 64, scr, lane); }
          else if (tn <= 0) for (int it = gw; it < 32 * 64 + 2 * 64 * 64; it += NGW) {
              if (it < 32 * 64) tr_job(args.in[22], PW, DM, WUPP, 0, 0, it, scr, lane);
              else if (it < 32 * 64 + 64 * 64) tr_job(args.in[23], LW, DM, WUPL, 0, 0, it - 32 * 64, scr, lane);
              else tr_job(args.in[24], DM, DM, WOUT, 0, 0, it - 32 * 64 - 64 * 64, scr, lane); } }
        if (BOTH(4)) GRID_BAR();
    }
    if (IN(5)) { PHASE_IDS;
        for (int i = gtid; i < 4 * 86 * 256 + 8 * 2 * 256; i += NT) {
            int v, t0, R, rowbase, nh; const float* hist = nullptr;
            if (i < 4 * 86 * 256) { v = i & 255; const int q = i >> 8, seq = q / 86; t0 = (q - seq * 86) * 24; R = 24; rowbase = seq * TP; nh = 0; }
            else { const int j = i - 4 * 86 * 256; v = j & 255; const int q = j >> 8, sb = q >> 1; t0 = (q & 1) * 16; R = 16; rowbase = MPROMPT + sb * TS; nh = 15; hist = state_pool + (size_t)sb * 15 * PW; }
            const int c0 = v * 8, w = 2 << (v >> 6);
            const bf16* zp = ZB + (size_t)rowbase * INW + c0;
            float s[8];
#pragma unroll
            for (int e = 0; e < 8; ++e) s[e] = 0.f;
            for (int k = 1; k < w; ++k) { const int tt = t0 - k;
                if (tt >= 0) { const v4u zw = *(const v4u*)(zp + (size_t)tt * INW);
                    s[0] += bflo(zw.x); s[1] += bfhi(zw.x); s[2] += bflo(zw.y); s[3] += bfhi(zw.y); s[4] += bflo(zw.z); s[5] += bfhi(zw.z); s[6] += bflo(zw.w); s[7] += bfhi(zw.w); }
                else if (hist) { const float* hp = hist + (size_t)(15 + tt) * PW + c0; const f32x4 a = *(const f32x4*)hp, b = *(const f32x4*)(hp + 4);
                    s[0] += a.x; s[1] += a.y; s[2] += a.z; s[3] += a.w; s[4] += b.x; s[5] += b.y; s[6] += b.z; s[7] += b.w; } }
            for (int r = 0; r < R; ++r) { const int t = t0 + r;
                const v4u zw = *(const v4u*)(zp + (size_t)t * INW);
                const float cur[8] = {bflo(zw.x), bfhi(zw.x), bflo(zw.y), bfhi(zw.y), bflo(zw.z), bfhi(zw.z), bflo(zw.w), bfhi(zw.w)};
                const int cnt = (nh + 1 + t) < w ? (nh + 1 + t) : w; const float inv = 1.0f / (float)cnt;
                float d[8];
#pragma unroll
                for (int e = 0; e < 8; ++e) { s[e] += cur[e]; d[e] = s[e] * inv - cur[e]; }
                v4u o; o.x = pk2(d[0], d[1]); o.y = pk2(d[2], d[3]); o.z = pk2(d[4], d[5]); o.w = pk2(d[6], d[7]);
                *(v4u*)(DB + (size_t)(rowbase + t) * PW + c0) = o;
                const int tt = t - w + 1;
                if (tt >= 0) { const v4u ow = *(const v4u*)(zp + (size_t)tt * INW);
                    s[0] -= bflo(ow.x); s[1] -= bfhi(ow.x); s[2] -= bflo(ow.y); s[3] -= bfhi(ow.y); s[4] -= bflo(ow.z); s[5] -= bfhi(ow.z); s[6] -= bflo(ow.w); s[7] -= bfhi(ow.w); }
                else if (hist) { const float* hp = hist + (size_t)(15 + tt) * PW + c0; const f32x4 a = *(const f32x4*)hp, b = *(const f32x4*)(hp + 4);
                    s[0] -= a.x; s[1] -= a.y; s[2] -= a.z; s[3] -= a.w; s[4] -= b.x; s[5] -= b.y; s[6] -= b.z; s[7] -= b.w; } }
        }
        const float* conv_w = args.in[13]; const float* conv_b = args.in[14];
        for (int i = gtid; i < 4 * 48 * 512 + 8 * 2 * 512; i += NT) {
            int v, t0, R, rowbase; const float* hist = nullptr;
            if (i < 4 * 48 * 512) { v = i & 511; const int q = i >> 9, seq = q / 48; t0 = (q - seq * 48) * 43; R = 43; rowbase = seq * TP; }
            else { const int j = i - 4 * 48 * 512; v = j & 511; const int q = j >> 9, sb = q >> 1; t0 = (q & 1) * 16; R = 16; rowbase = MPROMPT + sb * TS; hist = state_conv + (size_t)sb * 3 * LW; }
            const int c0 = v * 8;
            const bf16* zp = ZB + (size_t)rowbase * INW + PW + c0;
            float wk[4][8], bb[8], zh[3][8];
#pragma unroll
            for (int k = 0; k < 4; ++k) { const f32x4 w0 = *(const f32x4*)(conv_w + (size_t)k * LW + c0), w1 = *(const f32x4*)(conv_w + (size_t)k * LW + c0 + 4);
                wk[k][0] = w0.x; wk[k][1] = w0.y; wk[k][2] = w0.z; wk[k][3] = w0.w; wk[k][4] = w1.x; wk[k][5] = w1.y; wk[k][6] = w1.z; wk[k][7] = w1.w; }
            { const f32x4 b0 = *(const f32x4*)(conv_b + c0), b1 = *(const f32x4*)(conv_b + c0 + 4); bb[0] = b0.x; bb[1] = b0.y; bb[2] = b0.z; bb[3] = b0.w; bb[4] = b1.x; bb[5] = b1.y; bb[6] = b1.z; bb[7] = b1.w; }
#pragma unroll
            for (int k = 0; k < 3; ++k) { const int tt = t0 - 3 + k;
#pragma unroll
                for (int e = 0; e < 8; ++e) zh[k][e] = 0.f;
                if (tt >= 0) { const v4u zw = *(const v4u*)(zp + (size_t)tt * INW);
                    zh[k][0] = bflo(zw.x); zh[k][1] = bfhi(zw.x); zh[k][2] = bflo(zw.y); zh[k][3] = bfhi(zw.y); zh[k][4] = bflo(zw.z); zh[k][5] = bfhi(zw.z); zh[k][6] = bflo(zw.w); zh[k][7] = bfhi(zw.w); }
                else if (hist) { const float* hp = hist + (size_t)(3 + tt) * LW + c0; const f32x4 h0 = *(const f32x4*)hp, h1 = *(const f32x4*)(hp + 4);
                    zh[k][0] = h0.x; zh[k][1] = h0.y; zh[k][2] = h0.z; zh[k][3] = h0.w; zh[k][4] = h1.x; zh[k][5] = h1.y; zh[k][6] = h1.z; zh[k][7] = h1.w; } }
            for (int r = 0; r < R; ++r) { const int t = t0 + r;
                const v4u zw = *(const v4u*)(zp + (size_t)t * INW);
                const float cur[8] = {bflo(zw.x), bfhi(zw.x), bflo(zw.y), bfhi(zw.y), bflo(zw.z), bfhi(zw.z), bflo(zw.w), bfhi(zw.w)};
                float a[8];
#pragma unroll
                for (int e = 0; e < 8; ++e) { a[e] = bb[e] + zh[0][e] * wk[0][e] + zh[1][e] * wk[1][e] + zh[2][e] * wk[2][e] + cur[e] * wk[3][e]; zh[0][e] = zh[1][e]; zh[1][e] = zh[2][e]; zh[2][e] = cur[e]; }
                v4u o; o.x = pk2(a[0], a[1]); o.y = pk2(a[2], a[3]); o.z = pk2(a[4], a[5]); o.w = pk2(a[6], a[7]);
                *(v4u*)(XB + (size_t)(rowbase + t) * LW + c0) = o; }
        }
        for (int i = gtid; i < NBP * 15 * PW; i += NT) { const int c = i % PW, j = (i / PW) % 15, b = i / (15 * PW); out[O_PP + i] = __builtin_bit_cast(float, (unsigned)ZB[(size_t)(b * TP + TP - 15 + j) * INW + c] << 16); }
        for (int i = gtid; i < NBP * 3 * LW; i += NT) { const int c = i % LW, j = (i / LW) % 3, b = i / (3 * LW); out[O_CP + i] = __builtin_bit_cast(float, (unsigned)ZB[(size_t)(b * TP + TP - 3 + j) * INW + PW + c] << 16); }
        for (int i = gtid; i < NBS * 15 * PW; i += NT) { const int c = i % PW, j = (i / PW) % 15, b = i / (15 * PW); out[O_PS + i] = __builtin_bit_cast(float, (unsigned)ZB[(size_t)(MPROMPT + b * TS + TS - 15 + j) * INW + c] << 16); }
        for (int i = gtid; i < NBS * 3 * LW; i += NT) { const int c = i % LW, j = (i / LW) % 3, b = i / (3 * LW); out[O_CS + i] = __builtin_bit_cast(float, (unsigned)ZB[(size_t)(MPROMPT + b * TS + TS - 3 + j) * INW + PW + c] << 16); }
        if (BOTH(5)) GRID_BAR();
    }
    if (IN(6)) { PHASE_IDS;
        { pg8::Gemm g{DB, WPOOL, PW, 512, 512, 2, 512}; pg8::StaticOrder S; S.init(MPAD, PW, G, bx);
          EpiPool E{YA, args.in[12]};
          pg8::gemm_phase<EpiPool, pg8::StaticOrder, PG8_ALIGN, PG8_SP2>(lds + RING_OFF, g, S, E, wave); }
        { pg8::Gemm g{XB, WLRU, LW, 256, 256, 2, 256}; pg8::StaticOrder S; S.init(MPAD, 2 * LW, G, G - 1 - bx);
          EpiLru E{ABW, XB, args.in[16], args.in[18], CVB};
          pg8::gemm_phase<EpiLru, pg8::StaticOrder, PG8_ALIGN, PG8_SP2>(lds + RING_OFF, g, S, E, wave); }
        if (BOTH(6)) GRID_BAR();
    }
    if (IN(7)) { PHASE_IDS;
        LAS float* cs = (LAS float*)(lds + RING_OFF);
        for (int item = bx; item < NBP * 64; item += G) {
            const int seq = item >> 6, ch = (item & 63) * 64 + lane, c = wave;
            const size_t r0 = (size_t)seq * TP + (size_t)c * 258;
            const unsigned* ap = ABW + r0 * LW + ch;
            float h = 0.f, S = 0.f;
            for (int s = 0; s < 240; s += 24) scan_blk1<24>(ap + (size_t)s * LW, h, S);
            scan_blk1<18>(ap + (size_t)240 * LW, h, S);
            cs[(c * 64 + lane) * 2] = __expf(S); cs[(c * 64 + lane) * 2 + 1] = h;
            __syncthreads();
            float hc = 0.f;
            for (int k = 0; k < c; ++k) hc = cs[(k * 64 + lane) * 2] * hc + cs[(k * 64 + lane) * 2 + 1];
            __syncthreads();
            h = hc;
            const bf16* gp = ZB + r0 * INW + (PW + LW) + ch; bf16* yp = YB + r0 * LW + ch;
            for (int s = 0; s < 256; s += 16) scan_blk3<16>(ap + (size_t)s * LW, gp + (size_t)s * INW, yp + (size_t)s * LW, h);
            scan_blk3<2>(ap + (size_t)256 * LW, gp + (size_t)256 * INW, yp + (size_t)256 * LW, h);
            if (c == 7) out[O_LP + (size_t)seq * LW + ch] = h;
        }
        for (int base = bx * 128; base < NBS * LW; base += G * 128) {
            if (tid < 128) { const int idx = base + tid, sb = idx >> 12, ch = idx & 4095;
                float h = state_lru[idx];
                const size_t r0 = (size_t)MPROMPT + (size_t)sb * TS;
                for (int s = 0; s < TS; s += 16) scan_blk3<16>(ABW + (r0 + s) * LW + ch, ZB + (r0 + s) * INW + (PW + LW) + ch, YB + (r0 + s) * LW + ch, h);
                out[O_LS + idx] = h; }
        }
        if (BOTH(7)) GRID_BAR();
    }
    if (IN(8)) { PHASE_IDS;
        pg8::Gemm g{YA, WUPP, PW, PW, PW, 1 << 20, 0}; pg8::SplitTailOrder S; S.init(DM, PW / 64, G, bx);
        EpiUpPool E{MPB, GT, SLAB2};
        pg8::gemm_phase<EpiUpPool, pg8::SplitTailOrder, PG8_ALIGN, PG8_SP2>(lds + RING_OFF, g, S, E, wave);
        if (!BOTH(8)) {} else VM_WAIT();
    }
    if (IN(9)) { PHASE_IDS;
        pg8::Gemm g{YB, WUPL, LW, LW, LW, 1 << 20, 0}; pg8::SplitTailOrder S; S.init(DM, LW / 64, G, bx);
        EpiUpLru E{MB, MPB, GT, SLAB2 + (size_t)256 * 65536, SLAB2};
        pg8::gemm_phase<EpiUpLru, pg8::SplitTailOrder, PG8_ALIGN, PG8_SP2>(lds + RING_OFF, g, S, E, wave);
        GRID_BAR();
        for (int i = gtid; i < 512 * 1024; i += NT) {
            const int row = 8192 + (i >> 10), col = (i & 1023) * 4;
            const float* sp = SLAB2 + (size_t)(256 + (((row - 8192) >> 8) * 16 + (col >> 8)) * 8) * 65536 + (size_t)(row & 255) * 256 + (col & 255);
            f32x4 a = *(const f32x4*)sp;
#pragma unroll
            for (int ks = 1; ks < 8; ++ks) a += *(const f32x4*)(sp + (size_t)ks * 65536);
            v2u w; w.x = pg8::cvt_pk_bf16(a.x, a.y); w.y = pg8::cvt_pk_bf16(a.z, a.w);
            *(v2u*)(MB + (size_t)row * DM + col) = w;
        }
        if (BOTH(9)) GRID_BAR();
    }
    if (IN(10)) { PHASE_IDS;
        pg8::Gemm g{MB, WOUT, DM, DM, DM, 1 << 20, 0}; pg8::SplitTailOrder S; S.init(DM, DM / 64, G, bx);
        EpiResid<1> E{VB, X1B, nullptr, nullptr, nullptr, 1.0f, SLAB};
        pg8::gemm_phase<EpiResid<1>, pg8::SplitTailOrder, PG8_ALIGN, PG8_SP2>(lds + RING_OFF, g, S, E, wave);
        if (BOTH(10)) GRID_BAR();
    }
    if (IN(11)) { PHASE_IDS;
        ln_rows<0, 1, true>(VB, SLAB, X1B, nullptr, nullptr, nullptr, 1.0f, args.in[25], args.in[26], out, XB, nullptr, gw, NGW, lane, X2Q, RS2);
        if (BOTH(11)) GRID_BAR();
    }
    if (IN(12)) { PHASE_IDS;
        pg8::Gemm g{(const bf16*)X2Q, WFA, DM / 2, DM / 2, DM / 2, 1 << 20, 0}; pg8::StaticOrder S; S.init(MPAD, 2 * DFF, G, bx);
        EpiSwigluI8 E{(unsigned char*)HB, RS2, CMAX2};
        pg8::gemm_phase<EpiSwigluI8, pg8::StaticOrder, PG8_ALIGN, PG8_SP2, 2>(lds + RING_OFF, g, S, E, wave);
        { const int tr = TAIL_RANK(34 * 86), tn = TAIL_WGS(34 * 86);
          if (tr >= 0) for (int it = tr * NWAVES + wave; it < 86 * 64; it += tn * NWAVES) { const int kb = it >> 6, nb = it & 63; tr_item8(args.in[28], DM, (unsigned char*)WFB, DFF, 128 * kb, 64 * nb, 64 * nb, scr, lane, 128.f); } }
        if (BOTH(12)) GRID_BAR();
    }
    if (IN(13)) { PHASE_IDS;
        pg8::Gemm g{HB, WFB, DFF / 2, DFF / 2, DFF / 2, 1 << 20, 0}; pg8::SplitTailOrder S; S.init(DM, DFF / 128, G, bx);
        EpiResid<1> E{VB, XB, nullptr, nullptr, nullptr, 0.5f / 512.f, SLAB};
        pg8::gemm_phase<EpiResid<1>, pg8::SplitTailOrder, PG8_ALIGN, PG8_SP2, true>(lds + RING_OFF, g, S, E, wave);
        if (BOTH(13)) GRID_BAR();
    }
    if (IN(14)) { PHASE_IDS;
        ln_rows<1, 1>(VB, SLAB, XB, nullptr, nullptr, nullptr, 0.5f / 512.f, args.in[29], args.in[30], nullptr, XB, out, gw, NGW, lane);
    }
#undef IN
#undef BOTH
#undef GRID_BAR
}

#ifndef MK_N_LAUNCHES
#define MK_N_LAUNCHES 1
#endif
extern "C" void kernel_launch(void* const* d_in, const int* in_sizes, int n_in, void* d_out, int out_size, void* d_ws, size_t ws_size, hipStream_t stream) {
    static int grid = 0;
    if (grid == 0) {
        if (n_in != 31 || (size_t)out_size != O_END || ws_size < WS_END) { fprintf(stderr, "kernel_launch: unexpected problem (n_in %d, out %d, ws %zu, need %zu); nothing launched\n", n_in, out_size, ws_size, (size_t)WS_END); grid = -1; return; }
        int dev = 0, cus = 0, per_cu = 0;
        if (hipGetDevice(&dev) != hipSuccess || hipDeviceGetAttribute(&cus, hipDeviceAttributeMultiprocessorCount, dev) != hipSuccess) { fprintf(stderr, "kernel_launch: device query failed\n"); grid = -1; return; }
        if (hipFuncSetAttribute((const void*)mk_fwd, hipFuncAttributeMaxDynamicSharedMemorySize, LDS_BYTES) != hipSuccess) { fprintf(stderr, "kernel_launch: hipFuncSetAttribute failed\n"); grid = -1; return; }
        if (hipOccupancyMaxActiveBlocksPerMultiprocessor(&per_cu, (const void*)mk_fwd, NWAVES * 64, LDS_BYTES) != hipSuccess || per_cu < 1)
            fprintf(stderr, "kernel_launch: note: occupancy query reports %d workgroups per CU\n", per_cu);
        (void)hipGetLastError();
        grid = cus;
    }
    if (grid < 0) return;
    if (hipMemsetAsync((char*)d_ws + WS_CTL, 0, CTL_ZERO_BYTES, stream) != hipSuccess) { fprintf(stderr, "kernel_launch: memset failed\n"); return; }
    Args a{};
    for (int i = 0; i < 31; ++i) a.in[i] = (const float*)d_in[i];
    a.out = (float*)d_out; a.ws = (unsigned char*)d_ws;
#if MK_N_LAUNCHES == 1
    a.ph_lo = 0; a.ph_hi = NPHASE; a.li = 0;
    hipLaunchKernelGGL(mk_fwd, dim3(grid), dim3(NWAVES * 64), LDS_BYTES, stream, a);
#else
    for (int li = 0; li < NPHASE; ++li) { a.ph_lo = li; a.ph_hi = li + 1; a.li = 0; hipLaunchKernelGGL(mk_fwd, dim3(grid), dim3(NWAVES * 64), LDS_BYTES, stream, a); }
#endif
    const hipError_t le = hipPeekAtLastError();
    if (le != hipSuccess) fprintf(stderr, "kernel_launch: launch failed: %s\n", hipGetErrorName(le));
}
```

```cpp
#include <hip/hip_runtime.h>
#include <cstdio>
#include <cstdint>

__device__ __forceinline__ int lane_now() { int l; asm volatile("v_mbcnt_lo_u32_b32 %0, -1, 0\n\tv_mbcnt_hi_u32_b32 %0, -1, %0" : "=v"(l)); return l; }
namespace pg8 {
#define PG8_LAS __attribute__((address_space(3)))
typedef unsigned short bf16_t;
typedef short bf16x8 __attribute__((ext_vector_type(8)));
typedef float f32x4 __attribute__((ext_vector_type(4)));
typedef unsigned u32x4 __attribute__((ext_vector_type(4)));
constexpr int BM = 256, BK = 64, HALF = 128, HTB = HALF * BK * 2  , STAGE_BYTES = 8 * HTB, NXCD = 8, WGM = 8;

__host__ __device__ __forceinline__ int lds_byte(int r, int c) { const int st = (r >> 4) * 2 + (c >> 5), rr = r & 15, cc = c & 31, ob = rr * 64 + cc * 2; return st * 1024 + (ob ^ (((ob >> 9) & 1) << 5)); }
__host__ __device__ __forceinline__ void stage_rc(int b, int& R, int& C) { const int st = b / 1024, sb = b % 1024, swz = sb ^ (((sb >> 9) & 1) << 5); R = (st >> 1) * 16 + swz / 64; C = (st & 1) * 32 + (swz % 64) / 2; }
__host__ __device__ __forceinline__ int perm32(int rho) { const int n = rho >> 4, i = rho & 15; return 8 * (i >> 2) + 4 * n + (i & 3); }

struct Unit { int pm, pn, kt0, nk, slab; };
struct Gemm { const bf16_t* A; const bf16_t* Bt; int lda, ldb, K, tpg, agoff; };

struct StaticOrder {
    int nM, nN, nwg, G, c;
    __host__ __device__ void init(int M, int N, int G_, int c_) { nM = M / BM; nN = N / BM; nwg = nM * nN; G = G_; c = c_; }
    __host__ __device__ bool next(int i, Unit& u) const { return at((long)i * G + c, u); }
    __host__ __device__ bool at(long L, Unit& u) const {
        if (L >= nwg) return false;
        int wgid = (int)L; { const int q = nwg / NXCD, r = nwg % NXCD, xcd = wgid % NXCD, off = wgid / NXCD; wgid = (xcd < r ? xcd * (q + 1) : r * (q + 1) + (xcd - r) * q) + off; }
        const int nig = WGM * nN, gid = wgid / nig, fm = gid * WGM, gsz = (nM - fm) < WGM ? (nM - fm) : WGM;
        u.pm = fm + ((wgid % nig) % gsz); u.pn = (wgid % nig) / gsz; u.kt0 = 0; u.nk = -1; u.slab = -1; return true;
    }
    __device__ __forceinline__ void a_ready(const Unit&) const {}
    __device__ __forceinline__ void done(const Unit&) const {}
};

typedef float f32x2_t __attribute__((ext_vector_type(2)));
typedef __bf16 bf16x2_t __attribute__((ext_vector_type(2)));
struct SplitTailOrder {
    StaticOrder so; int nN, base, rem2;
    __host__ __device__ void init(int N, int ktiles, int G_, int c_) { so.init(32 * BM, N, G_, c_); nN = N / BM; base = (ktiles / 8) & ~1; rem2 = (ktiles - 8 * base) / 2; }
    __host__ __device__ bool next(int i, Unit& u) const {
        const long L = (long)i * so.G + so.c;
        if (L < so.nwg) return so.next(i, u);
        const int Lp = (int)(L - so.nwg); if (Lp >= 2 * nN * 8) return false;
        const int ks = Lp & 7, tile = Lp >> 3;
        u.pm = 32 + tile / nN; u.pn = tile % nN; u.kt0 = ks * base + 2 * (ks < rem2 ? ks : rem2); u.nk = base + (ks < rem2 ? 2 : 0); u.slab = tile * 8 + ks; return true;
    }
    __device__ __forceinline__ void a_ready(const Unit&) const {}
    __device__ __forceinline__ void done(const Unit&) const {}
};

struct Z8Order {
    StaticOrder sa, sb; int G, c;
    __host__ __device__ void init(int G_, int c_) { G = G_; c = c_; sa.init(34 * BM, 16 * BM, G_, 0); sb.init(29 * BM, 24 * BM, G_, 0); }
    __host__ __device__ bool next(int i, Unit& u) const {
        const long L = (long)i * G + c;
        if (L >= sb.nwg) { if (!sa.at(L - sb.nwg, u)) return false; u.pn += 24; return true; }
        sb.at(L, u);
        u.pm += (u.pm >= 8) ? 1 : 0; u.pm += (u.pm >= 16) ? 1 : 0; u.pm += (u.pm >= 24) ? 1 : 0; return true;
    }
    __device__ __forceinline__ void a_ready(const Unit&) const {}
    __device__ __forceinline__ void done(const Unit&) const {}
};
struct ZbOrder {
    StaticOrder so;
    __host__ __device__ void init(int G_, int c_) { so.init(5 * BM, 24 * BM, G_, c_); }
    __host__ __device__ bool next(int i, Unit& u) const { if (!so.next(i, u)) return false; u.pm = u.pm < 3 ? 8 * (u.pm + 1) : 29 + u.pm; return true; }
    __device__ __forceinline__ void a_ready(const Unit&) const {}
    __device__ __forceinline__ void done(const Unit&) const {}
};

__device__ __forceinline__ unsigned cvt_pk_bf16(float lo, float hi) { const f32x2_t v = {lo, hi}; return __builtin_bit_cast(unsigned, __builtin_convertvector(v, bf16x2_t)); }

typedef short s16x16 __attribute__((ext_vector_type(16)));
typedef int i32x8 __attribute__((ext_vector_type(8)));
typedef int i32x4 __attribute__((ext_vector_type(4)));
template <class Epi, class Sched, bool ALIGN_EPI = false, bool SP2 = false, int QT = 0>
__device__ __forceinline__ void gemm_phase(PG8_LAS unsigned char* lds, const Gemm g, const Sched& S, const Epi& E, const int wid  ) {
    const int lane = lane_now(), tid = (wid << 6) | lane, wr = wid >> 2, wc = wid & 3, fr = lane & 15, fq = lane >> 4;
    int Kop = g.K; asm volatile("" : "+s"(Kop));
    const int K = Kop, nt_full = K / BK;
    unsigned voffA[2], voffB[2];
#pragma unroll
    for (int i = 0; i < 2; ++i) { int R, C; stage_rc(tid * 16 + i * 8192, R, C); const int Rb = Epi::PERM ? ((R & ~31) + perm32(R & 31)) : R;
        voffA[i] = (unsigned)(R * g.lda + C) * 2u; voffB[i] = (unsigned)(Rb * g.ldb + C) * 2u; }
    const __amdgpu_buffer_rsrc_t rsA = __builtin_amdgcn_make_buffer_rsrc((void*)g.A, (short)0, 0x7fffffff, 0x00020000), rsB = __builtin_amdgcn_make_buffer_rsrc((void*)g.Bt, (short)0, 0x7fffffff, 0x00020000);
    const unsigned kstep = (unsigned)(BK * 2);
    const unsigned hstepA = (unsigned)HALF * g.lda * 2, hstepB = (unsigned)HALF * g.ldb * 2;
    const unsigned tstepA = 2 * hstepA, tstepB = 2 * hstepB;
    const unsigned ldsw = (unsigned)wid * 1024u;
    const int aoff = lds_byte(wr * 64 + fr, fq * 8), boff = lds_byte(wc * 32 + fr, fq * 8);
#define PG8_UA(u) ((unsigned)(u).pm * tstepA + (unsigned)((u).pn / g.tpg) * (unsigned)g.agoff * 2u)
#define PG8_UB(u) ((unsigned)(u).pn * tstepB)
#define PG8_SA(b, h) (((b) * 2 + (h)) * HTB)
#define PG8_SB(b, h) ((4 + (b) * 2 + (h)) * HTB)
#define PG8_STAGE(bufoff, soff, voff, rs) do { _Pragma("unroll") for (int _i = 0; _i < 2; ++_i) \
        __builtin_amdgcn_raw_ptr_buffer_load_lds(rs, (PG8_LAS unsigned*)(lds + (bufoff) + ldsw + _i * 8192), 16, (voff)[_i], (int)(soff), 0, 0); } while (0)
#define PG8_LDA(dst, b, h) do { _Pragma("unroll") for (int m = 0; m < 4; ++m) _Pragma("unroll") for (int k = 0; k < 2; ++k) dst[m][k] = *(const PG8_LAS bf16x8*)(lds + PG8_SA(b, h) + aoff + m * 2048 + k * 1024); } while (0)
#define PG8_LDB(dst, b, h) do { _Pragma("unroll") for (int n = 0; n < 2; ++n) _Pragma("unroll") for (int k = 0; k < 2; ++k) dst[n][k] = *(const PG8_LAS bf16x8*)(lds + PG8_SB(b, h) + boff + n * 2048 + k * 1024); } while (0)
#define PG8_CAT(a, b) __builtin_bit_cast(i32x8, __builtin_shufflevector(a, b, 0, 1, 2, 3, 4, 5, 6, 7, 8, 9, 10, 11, 12, 13, 14, 15))
#define PG8_MMA(ai, bj, At, Bt) do { __builtin_amdgcn_s_setprio(1); if constexpr (QT == 1) { _Pragma("unroll") for (int m = 0; m < 4; ++m) _Pragma("unroll") for (int n = 0; n < 2; ++n) \
        acc[ai][bj][m][n] = __builtin_amdgcn_mfma_scale_f32_16x16x128_f8f6f4(PG8_CAT(Bt[n][0], Bt[n][1]), PG8_CAT(At[m][0], At[m][1]), acc[ai][bj][m][n], 0, 0, 0, 127, 0, 127); } else if constexpr (QT == 2) { \
        _Pragma("unroll") for (int m = 0; m < 4; ++m) _Pragma("unroll") for (int n = 0; n < 2; ++n) _Pragma("unroll") for (int k = 0; k < 2; ++k) \
        acc[ai][bj][m][n] = __builtin_bit_cast(f32x4, __builtin_amdgcn_mfma_i32_16x16x64_i8(__builtin_bit_cast(i32x4, Bt[n][k]), __builtin_bit_cast(i32x4, At[m][k]), __builtin_bit_cast(i32x4, acc[ai][bj][m][n]), 0, 0, 0)); } else { \
        _Pragma("unroll") for (int m = 0; m < 4; ++m) _Pragma("unroll") for (int n = 0; n < 2; ++n) _Pragma("unroll") for (int k = 0; k < 2; ++k) \
        acc[ai][bj][m][n] = __builtin_amdgcn_mfma_f32_16x16x32_bf16(Bt[n][k], At[m][k], acc[ai][bj][m][n], 0, 0, 0); } __builtin_amdgcn_s_setprio(0); } while (0)
#define PG8_WAIT_V(n) asm volatile("s_waitcnt vmcnt(" #n ")" ::: "memory")
#define PG8_WAIT_L(n) asm volatile("s_waitcnt lgkmcnt(" #n ")" ::: "memory")
#define PG8_BAR __builtin_amdgcn_s_barrier()
#define PG8_SCHED __builtin_amdgcn_sched_barrier(0)
    Unit cur, nxt; int ui = 0;
    if (!S.next(0, cur)) return;
    f32x4 acc[2][2][4][2];
#pragma unroll
    for (int a = 0; a < 2; ++a)
#pragma unroll
        for (int b = 0; b < 2; ++b)
#pragma unroll
            for (int m = 0; m < 4; ++m)
#pragma unroll
                for (int n = 0; n < 2; ++n) acc[a][b][m][n] = (f32x4){0.f, 0.f, 0.f, 0.f};
    bf16x8 At[4][2], B0[2][2], B1[2][2];
    unsigned cA = PG8_UA(cur) + (unsigned)cur.kt0 * kstep, cB = PG8_UB(cur) + (unsigned)cur.kt0 * kstep;
    int nt = cur.nk < 0 ? nt_full : cur.nk;
    S.a_ready(cur);
    if constexpr (SP2) {
        PG8_STAGE(PG8_SB(0, 0), cB, voffB, rsB); PG8_STAGE(PG8_SB(0, 1), cB + hstepB, voffB, rsB); PG8_STAGE(PG8_SA(0, 0), cA, voffA, rsA); PG8_STAGE(PG8_SA(0, 1), cA + hstepA, voffA, rsA);
        if (wr == 1) PG8_BAR;
        PG8_WAIT_V(2); PG8_BAR;
        PG8_STAGE(PG8_SB(1, 0), cB + kstep, voffB, rsB); PG8_STAGE(PG8_SA(1, 0), cA + kstep, voffA, rsA); PG8_STAGE(PG8_SB(1, 1), cB + hstepB + kstep, voffB, rsB);
        PG8_WAIT_V(6); PG8_BAR;
    } else {
        PG8_STAGE(PG8_SB(0, 0), cB, voffB, rsB); PG8_STAGE(PG8_SA(0, 0), cA, voffA, rsA); PG8_STAGE(PG8_SB(0, 1), cB + hstepB, voffB, rsB); PG8_STAGE(PG8_SA(0, 1), cA + hstepA, voffA, rsA);
        if (wr == 1) PG8_BAR;
        PG8_WAIT_V(4); PG8_BAR;
        PG8_STAGE(PG8_SB(1, 0), cB + kstep, voffB, rsB); PG8_STAGE(PG8_SA(1, 0), cA + kstep, voffA, rsA); PG8_STAGE(PG8_SB(1, 1), cB + hstepB + kstep, voffB, rsB);
        PG8_WAIT_V(6); PG8_BAR;
    }
    for (;;) {
        const bool has_next = S.next(ui + 1, nxt);
        const unsigned nA = has_next ? PG8_UA(nxt) + (unsigned)nxt.kt0 * kstep : cA, nB = has_next ? PG8_UB(nxt) + (unsigned)nxt.kt0 * kstep : cB;
        for (int t = 0; t < nt; t += 2) {
            const bool last = (t == nt - 2);
            const unsigned a1 = cA + (unsigned)(t + 1) * kstep;
            const unsigned a2 = last ? nA : cA + (unsigned)(t + 2) * kstep, b2 = last ? nB : cB + (unsigned)(t + 2) * kstep;
            const unsigned a3 = a2 + kstep, b3 = b2 + kstep;
            if (last && has_next) S.a_ready(nxt);
            if constexpr (SP2) {
            PG8_LDB(B0, 0, 0); PG8_LDB(B1, 0, 1); PG8_SCHED; PG8_LDA(At, 0, 0); PG8_STAGE(PG8_SA(1, 1), a1 + hstepA, voffA, rsA);
            PG8_WAIT_V(8); PG8_WAIT_L(0); PG8_BAR; PG8_MMA(0, 0, At, B0); PG8_MMA(0, 1, At, B1); PG8_BAR; PG8_SCHED;
            PG8_LDA(At, 0, 1); PG8_STAGE(PG8_SB(0, 0), b2, voffB, rsB); PG8_STAGE(PG8_SB(0, 1), b2 + hstepB, voffB, rsB); PG8_STAGE(PG8_SA(0, 0), a2, voffA, rsA);
            PG8_WAIT_V(8); PG8_WAIT_L(0); PG8_BAR; PG8_MMA(1, 0, At, B0); PG8_MMA(1, 1, At, B1); PG8_BAR; PG8_SCHED;
            PG8_LDB(B0, 1, 0); PG8_LDB(B1, 1, 1); PG8_SCHED; PG8_LDA(At, 1, 0); PG8_STAGE(PG8_SA(0, 1), a2 + hstepA, voffA, rsA);
            PG8_WAIT_V(8); PG8_WAIT_L(0); PG8_BAR; PG8_MMA(0, 0, At, B0); PG8_MMA(0, 1, At, B1); PG8_BAR; PG8_SCHED;
            PG8_LDA(At, 1, 1); PG8_STAGE(PG8_SB(1, 0), b3, voffB, rsB); PG8_STAGE(PG8_SB(1, 1), b3 + hstepB, voffB, rsB); PG8_STAGE(PG8_SA(1, 0), a3, voffA, rsA);
            PG8_WAIT_V(8); PG8_WAIT_L(0); PG8_BAR; PG8_MMA(1, 0, At, B0); PG8_MMA(1, 1, At, B1); PG8_BAR; PG8_SCHED;
            } else {
            PG8_LDB(B0, 0, 0); PG8_SCHED; PG8_LDA(At, 0, 0); PG8_STAGE(PG8_SA(1, 1), a1 + hstepA, voffA, rsA);
            PG8_WAIT_L(8); PG8_BAR; PG8_WAIT_L(0); PG8_MMA(0, 0, At, B0); PG8_BAR; PG8_SCHED;
            PG8_LDB(B1, 0, 1); PG8_STAGE(PG8_SB(0, 0), b2, voffB, rsB);
            PG8_BAR; PG8_WAIT_L(0); PG8_MMA(0, 1, At, B1); PG8_BAR;
            PG8_LDA(At, 0, 1); PG8_STAGE(PG8_SA(0, 0), a2, voffA, rsA);
            PG8_BAR; PG8_WAIT_L(0); PG8_MMA(1, 0, At, B0); PG8_BAR; PG8_SCHED;
            PG8_STAGE(PG8_SB(0, 1), b2 + hstepB, voffB, rsB);
            PG8_WAIT_V(6); PG8_BAR; PG8_MMA(1, 1, At, B1); PG8_BAR;
            PG8_LDB(B0, 1, 0); PG8_SCHED; PG8_LDA(At, 1, 0); PG8_STAGE(PG8_SA(0, 1), a2 + hstepA, voffA, rsA);
            PG8_WAIT_L(8); PG8_BAR; PG8_WAIT_L(0); PG8_MMA(0, 0, At, B0); PG8_BAR; PG8_SCHED;
            PG8_LDB(B1, 1, 1); PG8_STAGE(PG8_SB(1, 0), b3, voffB, rsB);
            PG8_BAR; PG8_WAIT_L(0); PG8_MMA(0, 1, At, B1); PG8_BAR;
            PG8_LDA(At, 1, 1); PG8_STAGE(PG8_SA(1, 0), a3, voffA, rsA);
            PG8_BAR; PG8_WAIT_L(0); PG8_MMA(1, 0, At, B0); PG8_BAR; PG8_SCHED;
            PG8_STAGE(PG8_SB(1, 1), b3 + hstepB, voffB, rsB);
            PG8_WAIT_V(6); PG8_BAR; PG8_MMA(1, 1, At, B1); PG8_BAR;
            }
        }
        if constexpr (ALIGN_EPI) { if (wr == 0) PG8_BAR; }
        { const int l_e = lane_now(); const int fr_e = l_e & 15, fq_e = l_e >> 4;
          E(acc, cur, wr, wc, fr_e, fq_e); } S.done(cur);
        if (!has_next) break;
#pragma unroll
        for (int a = 0; a < 2; ++a)
#pragma unroll
            for (int b = 0; b < 2; ++b)
#pragma unroll
                for (int m = 0; m < 4; ++m)
#pragma unroll
                    for (int n = 0; n < 2; ++n) acc[a][b][m][n] = (f32x4){0.f, 0.f, 0.f, 0.f};
        cur = nxt; cA = nA; cB = nB; ++ui; nt = cur.nk < 0 ? nt_full : cur.nk;
        if constexpr (ALIGN_EPI) { if (wr == 1) PG8_BAR; }
    }
    PG8_WAIT_V(0);
    if constexpr (!ALIGN_EPI) { if (wr == 0) PG8_BAR; }
    PG8_BAR;
#undef PG8_UA
#undef PG8_UB
#undef PG8_SA
#undef PG8_SB
#undef PG8_STAGE
#undef PG8_LDA
#undef PG8_LDB
#undef PG8_MMA
#undef PG8_CAT
#undef PG8_WAIT_V
#undef PG8_WAIT_L
#undef PG8_BAR
#undef PG8_SCHED
}
}

#ifndef PG8_SP2
#define PG8_SP2 true
#endif
#ifndef PG8_ALIGN
#define PG8_ALIGN true
#endif

constexpr int NWAVES = 8;
constexpr int DM = 4096, DFF = 11008, PW = 2048, LW = 4096, INW = 10240, NGATE = 8192;
constexpr int NBP = 4, TP = 2064, NBS = 8, TS = 32, NMETA = 16, SEQ = 2048;
constexpr int MPROMPT = NBP * TP;
constexpr int MREAL = MPROMPT + NBS * TS;
constexpr int MPAD = 8704;
constexpr float ALPHA = 1.189207115002721f;
constexpr float LN_EPS = 1e-5f;
constexpr int NPHASE = 15;
constexpr size_t O_YP = 0, O_YS = 33554432, O_PP = 34603008, O_CP = 34725888, O_LP = 34775040, O_PS = 34791424, O_CS = 35037184, O_LS = 35135488, O_END = 35168256;

constexpr size_t MiB = 1u << 20;
constexpr size_t WS_CTL = 0, CTL_ZERO_BYTES = 1024 * 1024;
constexpr size_t WS_CMAX1 = 256 * 1024, WS_CMAX2 = 384 * 1024, WS_CMAXG = 512 * 1024;
constexpr size_t WS_CMAXZ = 896 * 1024;
constexpr size_t WS_RS0 = 640 * 1024, WS_RS1 = 704 * 1024, WS_RS2 = 768 * 1024;
constexpr size_t WS_WMIX = 1 * MiB, WS_WPOOL = 145 * MiB, WS_WLRU = 147 * MiB, WS_WUPP = 151 * MiB, WS_WUPL = 167 * MiB, WS_WOUT = 199 * MiB;
constexpr size_t WS_WFA = 231 * MiB, WS_WFB = 403 * MiB;
constexpr size_t WS_XB = 489 * MiB;
constexpr size_t WS_H = 557 * MiB;
constexpr size_t WS_A = WS_H, WS_D = WS_H + 136 * MiB;
constexpr size_t WS_V = 740 * MiB;
constexpr size_t WS_MP = WS_V;
constexpr size_t WS_X1F = 876 * MiB;
constexpr size_t WS_BX = 1012 * MiB, WS_X2F = WS_BX, WS_WZB = WS_BX;
constexpr size_t WS_Z = 1148 * MiB, WS_MB = WS_Z;
constexpr size_t WS_GATES = 1318 * MiB;
constexpr size_t WS_YA = 1454 * MiB, WS_YB = 1488 * MiB;
constexpr size_t WS_CV = 1556 * MiB;
constexpr size_t WS_END = 1557 * MiB;
static_assert(WS_D + (size_t)MPAD * PW * 2 <= WS_V && WS_H + (size_t)MPAD * DFF * 2 <= WS_V, "ws map");

constexpr int CW_TMO = 0, CW_CODE = 1;
constexpr int CW_BAR = 4096;

constexpr int RING_OFF = 0, RING_BYTES = 131072;
constexpr int LDSCTL_OFF = RING_BYTES, MISC_OFF = LDSCTL_OFF + 320;
constexpr int LDS_BYTES = 147456;

#define GAS __attribute__((address_space(1)))
#define LAS __attribute__((address_space(3)))
typedef unsigned short bf16;
typedef unsigned v4u __attribute__((ext_vector_type(4)));
typedef unsigned v2u __attribute__((ext_vector_type(2)));
typedef float f32x4 __attribute__((ext_vector_type(4)));
typedef int i32x4_t __attribute__((ext_vector_type(4)));
typedef GAS unsigned gu32;
#define RLX_AGENT __ATOMIC_RELAXED, __HIP_MEMORY_SCOPE_AGENT
#define LDS_WAIT() asm volatile("s_waitcnt lgkmcnt(0)" ::: "memory")
#define VM_WAIT() asm volatile("s_waitcnt vmcnt(0)" ::: "memory")
__device__ __forceinline__ unsigned f2bf(float f) { unsigned u = __builtin_bit_cast(unsigned, f); return (u + 0x7fffu + ((u >> 16) & 1u)) >> 16; }
__device__ __forceinline__ unsigned pk2(float lo, float hi) { return f2bf(lo) | (f2bf(hi) << 16); }
__device__ __forceinline__ float bflo(unsigned w) { return __builtin_bit_cast(float, w << 16); }
__device__ __forceinline__ float bfhi(unsigned w) { return __builtin_bit_cast(float, w & 0xffff0000u); }
#define PK8(a, b, old, hi) __builtin_amdgcn_cvt_pk_fp8_f32(__builtin_amdgcn_fmed3f((a), -448.f, 448.f), __builtin_amdgcn_fmed3f((b), -448.f, 448.f), (old), (hi))
__device__ __forceinline__ float sigm(float x) { return __builtin_amdgcn_rcpf(1.0f + __expf(-x)); }
__device__ __forceinline__ int q8i(float x) { return (int)__builtin_rintf(x); }
__device__ __forceinline__ unsigned pack4(int a, int b, int c, int d) { return (unsigned)(a & 255) | ((unsigned)(b & 255) << 8) | ((unsigned)(c & 255) << 16) | ((unsigned)d << 24); }
__device__ __forceinline__ float inv127(unsigned mbits) { const float m = __builtin_bit_cast(float, mbits); return m > 0.f ? 127.f / m : 0.f; }
template <int N> __device__ __forceinline__ void sigmN(float (&x)[N]) {
#pragma unroll
    for (int i = 0; i < N; ++i) x[i] = __builtin_amdgcn_exp2f(x[i] * -1.4426950408889634f);
#pragma unroll
    for (int i = 0; i < N; ++i) x[i] = 1.0f + x[i];
#pragma unroll
    for (int i = 0; i < N; ++i) x[i] = __builtin_amdgcn_rcpf(x[i]);
}
__device__ __forceinline__ float gelu_tanh(float x) { const float t = 1.5957691216057308f * (x + 0.044715f * x * x * x); return x * sigm(t); }

#define XB_TMO      128
#define XB_XCNT(j)  (256  + 64 * (j))
#define XB_XSUB(j)  (1280 + 64 * (j))
#define XB_XGEN(j)  (2304 + 64 * (j))
#define XB_TOP      3328
#define XB_TOPGEN   3392
#define XCD_BAR_WORDS 3456
#define XB_SPIN_CAP (1u << 18)

__device__ __forceinline__ unsigned xb_ld(unsigned* p)              { return __hip_atomic_load(p, __ATOMIC_RELAXED, __HIP_MEMORY_SCOPE_AGENT); }
__device__ __forceinline__ unsigned xb_add(unsigned* p, unsigned v) { return __hip_atomic_fetch_add(p, v, __ATOMIC_RELAXED, __HIP_MEMORY_SCOPE_AGENT); }
__device__ __forceinline__ unsigned xb_xcc_id() { return (unsigned)__builtin_amdgcn_s_getreg((3 << 11) | 20) & 0xFu; }
#define XB_SPIN(cond, bar) do { unsigned _sp = 0; while (cond) { __builtin_amdgcn_s_sleep(1); \
    if ((++_sp & 255u) == 0u) { if (xb_ld(&(bar)[XB_TMO])) break; if (_sp > XB_SPIN_CAP) { atomicAdd(&(bar)[XB_TMO], 1u); break; } } } } while (0)

struct XcdBarrier {
    unsigned* bar; unsigned x;
    volatile LAS unsigned* st;
};
__device__ __forceinline__ XcdBarrier xcd_barrier_post(unsigned* bar, volatile LAS unsigned* st, bool t0  ) {
    XcdBarrier b; b.bar = bar; b.x = xb_xcc_id(); b.st = st;
    if (t0) (void)xb_add(&bar[XB_XCNT(b.x)], 1u);
    return b;
}
__device__ __forceinline__ void xcd_barrier_complete(unsigned* bar, unsigned x, unsigned& nloc, unsigned& nx) {
    const unsigned G = gridDim.x * gridDim.y * gridDim.z;
    unsigned sum, cnt, mine, sp = 0u;
    for (;;) {
        sum = 0u; cnt = 0u; mine = 0u;
#pragma unroll
        for (unsigned j = 0; j < 16; ++j) { const unsigned c = xb_ld(&bar[XB_XCNT(j)]); sum += c; cnt += (c > 0u) ? 1u : 0u; mine = (j == x) ? c : mine; }
        if (sum == G) break;
        __builtin_amdgcn_s_sleep(1);
        if ((++sp & 255u) == 0u) { if (xb_ld(&bar[XB_TMO])) break; if (sp > XB_SPIN_CAP) { atomicAdd(&bar[XB_TMO], 1u); break; } }
    }
    nloc = mine > 0u ? mine : 1u; nx = cnt > 0u ? cnt : 1u;
}
__device__ __forceinline__ void xcd_barrier(const XcdBarrier& b, bool t0  ) {
    asm volatile("s_waitcnt vmcnt(0)" ::: "memory");
    __syncthreads();
    if (t0) {
        unsigned* bar = b.bar;
        __builtin_amdgcn_s_waitcnt(0);
        unsigned nloc = b.st[0], nx = b.st[1];
        if (nloc == 0u) { xcd_barrier_complete(bar, b.x, nloc, nx); b.st[0] = nloc; b.st[1] = nx; }
        const unsigned old = xb_add(&bar[XB_XSUB(b.x)], 1u);
        const unsigned gen = old / nloc;
        if (old + 1u == (gen + 1u) * nloc) {
            __builtin_amdgcn_fence(__ATOMIC_RELEASE, "agent");
            asm volatile("s_waitcnt vmcnt(0)" ::: "memory");
            const unsigned og = xb_add(&bar[XB_TOP], 1u);
            const unsigned tg = og / nx;
            if (og + 1u == (tg + 1u) * nx) xb_add(&bar[XB_TOPGEN], 1u);
            else XB_SPIN(xb_ld(&bar[XB_TOPGEN]) == tg, bar);
            __builtin_amdgcn_fence(__ATOMIC_ACQUIRE, "agent");
            xb_add(&bar[XB_XGEN(b.x)], 1u);
            asm volatile("s_waitcnt vmcnt(0)" ::: "memory");
        } else {
            XB_SPIN(xb_ld(&bar[XB_XGEN(b.x)]) == gen, bar);
            __builtin_amdgcn_fence(__ATOMIC_ACQUIRE, "agent");
            asm volatile("s_waitcnt vmcnt(0)" ::: "memory");
        }
    }
    __syncthreads();
}

#define WDPP(x, ctrl) __builtin_bit_cast(float, __builtin_amdgcn_update_dpp(0, __builtin_bit_cast(int, (x)), (ctrl), 0xf, 0xf, false))
__device__ __forceinline__ float wave_sum(float v) {
    v += WDPP(v, 0xB1); v += WDPP(v, 0x4E); v += WDPP(v, 0x141); v += WDPP(v, 0x140);
    v += __shfl_xor(v, 16); v += __shfl_xor(v, 32);
    return v;
}
__device__ __forceinline__ float wave_max(float v) {
    v = fmaxf(v, WDPP(v, 0xB1)); v = fmaxf(v, WDPP(v, 0x4E)); v = fmaxf(v, WDPP(v, 0x141)); v = fmaxf(v, WDPP(v, 0x140));
    v = fmaxf(v, __shfl_xor(v, 16)); v = fmaxf(v, __shfl_xor(v, 32));
    return v;
}
__device__ __forceinline__ const float* x0_row(const float* xp, const float* xs, const float* meta, int row) {
    if (row < MPROMPT) { const int b = row / TP, t = row - b * TP; return t < NMETA ? meta + (size_t)t * DM : xp + ((size_t)b * SEQ + (t - NMETA)) * DM; }
    if (row < MREAL) return xs + (size_t)(row - MPROMPT) * DM;
    return nullptr;
}

__device__ __forceinline__ void tr_item(const float* W, int ldw, bf16* WT, int ldwt, int k0, int n0, int drow0, LAS unsigned* scr, int lane) {
    const int r = lane >> 4, c = lane & 15;
    const float* src = W + (size_t)(k0 + 2 * r) * ldw + n0 + 4 * c;
    f32x4 lo[8], hi[8];
#pragma unroll
    for (int j = 0; j < 8; ++j) { lo[j] = __builtin_nontemporal_load((const f32x4*)(src + (size_t)(8 * j) * ldw)); hi[j] = __builtin_nontemporal_load((const f32x4*)(src + (size_t)(8 * j + 1) * ldw)); }
#pragma unroll
    for (int j = 0; j < 8; ++j)
#pragma unroll
        for (int e = 0; e < 4; ++e) scr[(4 * c + e) * 32 + ((j ^ (c & 7)) * 4) + r] = pg8::cvt_pk_bf16(lo[j][e], hi[j][e]);
    LDS_WAIT(); asm volatile("" ::: "memory");
    const int q = lane & 7;
#pragma unroll
    for (int i = 0; i < 8; ++i) { const int n = (lane >> 3) + 8 * i; const v4u o = *(const LAS v4u*)(scr + n * 32 + ((q ^ ((n >> 2) & 7)) * 4));
        *(GAS v4u*)(WT + (size_t)(drow0 + n) * ldwt + k0 + 8 * q) = o; }
    LDS_WAIT(); asm volatile("" ::: "memory");
}
__device__ __forceinline__ void tr_item8(const float* W, int ldw, unsigned char* WT, int pitchB, int k0, int n0, int drow0, LAS unsigned* scr, int lane, float sc) {
    const int r = lane >> 4, c = lane & 15;
    const float* src = W + (size_t)(k0 + 4 * r) * ldw + n0 + 4 * c;
    f32x4 v[8][4];
#pragma unroll
    for (int j = 0; j < 8; ++j)
#pragma unroll
        for (int i = 0; i < 4; ++i) v[j][i] = __builtin_nontemporal_load((const f32x4*)(src + (size_t)(16 * j + i) * ldw));
#pragma unroll
    for (int j = 0; j < 8; ++j)
#pragma unroll
        for (int e = 0; e < 4; ++e) { int w = PK8(v[j][0][e] * sc, v[j][1][e] * sc, 0, false); w = PK8(v[j][2][e] * sc, v[j][3][e] * sc, w, true);
            scr[(4 * c + e) * 32 + ((j ^ (c & 7)) * 4) + r] = (unsigned)w; }
    LDS_WAIT(); asm volatile("" ::: "memory");
    const int q = lane & 7;
#pragma unroll
    for (int i = 0; i < 8; ++i) { const int n = (lane >> 3) + 8 * i; const v4u o = *(const LAS v4u*)(scr + n * 32 + ((q ^ ((n >> 2) & 7)) * 4));
        *(GAS v4u*)(WT + (size_t)(drow0 + n) * pitchB + k0 + 16 * q) = o; }
    LDS_WAIT(); asm volatile("" ::: "memory");
}
__device__ __forceinline__ void tr_job(const float* W, int K, int N, bf16* WT, int mode, int roff, int it, LAS unsigned* scr, int lane) {
    const int nblk = N / 64, kb = it / nblk, nb = it - kb * nblk, k0 = 64 * kb, n0 = 64 * nb;
    int drow0;
    if (mode == 0) drow0 = roff + n0;
    else if (mode == 1) { const int half = N >> 1; const bool up = n0 >= half; const int nn = up ? n0 - half : n0; drow0 = (nn >> 7) * 256 + (nn & 127) + (up ? 128 : 0); }
    else drow0 = roff + (n0 >> 7) * 256 + (n0 & 127);
    tr_item(W, N, WT, K, k0, n0, drow0, scr, lane);
}


__device__ __forceinline__ void tr_item_i8(const float* W, int ldw, unsigned char* WT, int pitchB, int k0, int n0, int drow0, LAS unsigned* scr, int lane, const unsigned* cmax) {
    const int r = lane >> 4, c = lane & 15;
    const float* src = W + (size_t)(k0 + 4 * r) * ldw + n0 + 4 * c;
    f32x4 v[8][4];
#pragma unroll
    for (int j = 0; j < 8; ++j)
#pragma unroll
        for (int i = 0; i < 4; ++i) v[j][i] = __builtin_nontemporal_load((const f32x4*)(src + (size_t)(16 * j + i) * ldw));
    const v4u cm = *(const v4u*)(cmax + n0 + 4 * c);
    const float inv[4] = {inv127(cm.x), inv127(cm.y), inv127(cm.z), inv127(cm.w)};
#pragma unroll
    for (int j = 0; j < 8; ++j)
#pragma unroll
        for (int e = 0; e < 4; ++e) scr[(4 * c + e) * 32 + ((j ^ (c & 7)) * 4) + r] = pack4(q8i(v[j][0][e] * inv[e]), q8i(v[j][1][e] * inv[e]), q8i(v[j][2][e] * inv[e]), q8i(v[j][3][e] * inv[e]));
    LDS_WAIT(); asm volatile("" ::: "memory");
    const int q = lane & 7;
#pragma unroll
    for (int i = 0; i < 8; ++i) { const int n = (lane >> 3) + 8 * i; const v4u o = *(const LAS v4u*)(scr + n * 32 + ((q ^ ((n >> 2) & 7)) * 4));
        *(GAS v4u*)(WT + (size_t)(drow0 + n) * pitchB + k0 + 16 * q) = o; }
    LDS_WAIT(); asm volatile("" ::: "memory");
}
__device__ __forceinline__ void tr_job_i8(const float* W, int K, int N, unsigned char* WT, int mode, int it, LAS unsigned* scr, int lane, const unsigned* cmax) {
    const int nblk = N / 64, kb = it / nblk, nb = it - kb * nblk, k0 = 128 * kb, n0 = 64 * nb;
    int drow0 = n0;
    if (mode == 1) { const int half = N >> 1; const bool up = n0 >= half; const int nn = up ? n0 - half : n0; drow0 = (nn >> 7) * 256 + (nn & 127) + (up ? 128 : 0); }
    tr_item_i8(W, N, WT, K, k0, n0, drow0, scr, lane, cmax);
}
template <bool NT> __device__ __forceinline__ void colmax_job(const float* W, int N, unsigned* cmax, int it, int lane) {
    const int nblk = N / 256, kc = it / nblk, nb = it - kc * nblk;
    const float* src = W + (size_t)(64 * kc) * N + 256 * nb + 4 * lane;
    f32x4 m = (f32x4){0.f, 0.f, 0.f, 0.f};
#pragma unroll 1
    for (int jj = 0; jj < 64; jj += 16) { f32x4 v[16];
#pragma unroll
        for (int i = 0; i < 16; ++i) v[i] = NT ? __builtin_nontemporal_load((const f32x4*)(src + (size_t)(jj + i) * N)) : *(const f32x4*)(src + (size_t)(jj + i) * N);
#pragma unroll
        for (int i = 0; i < 16; ++i) { m.x = fmaxf(m.x, fabsf(v[i].x)); m.y = fmaxf(m.y, fabsf(v[i].y)); m.z = fmaxf(m.z, fabsf(v[i].z)); m.w = fmaxf(m.w, fabsf(v[i].w)); } }
    unsigned* p = cmax + 256 * nb + 4 * lane;
    const v4u mb = __builtin_bit_cast(v4u, m);
    (void)__hip_atomic_fetch_max(p + 0, mb.x, RLX_AGENT); (void)__hip_atomic_fetch_max(p + 1, mb.y, RLX_AGENT);
    (void)__hip_atomic_fetch_max(p + 2, mb.z, RLX_AGENT); (void)__hip_atomic_fetch_max(p + 3, mb.w, RLX_AGENT);
}

template <int NB> __device__ __forceinline__ void scan_blk1(const unsigned* ap, float& h, float& S) {
    unsigned wv[NB];
#pragma unroll
    for (int i = 0; i < NB; ++i) wv[i] = ap[(size_t)i * LW];
#pragma unroll
    for (int i = 0; i < NB; ++i) { const float la = bflo(wv[i]); h = __expf(la) * h + bfhi(wv[i]); S += la; }
}
template <int NB> __device__ __forceinline__ void scan_blk3(const unsigned* ap, const bf16* gp, bf16* yp, float& h) {
    unsigned wv[NB], gv[NB];
#pragma unroll
    for (int i = 0; i < NB; ++i) { wv[i] = ap[(size_t)i * LW]; gv[i] = gp[(size_t)i * INW]; }
#pragma unroll
    for (int i = 0; i < NB; ++i) { h = __expf(bflo(wv[i])) * h + bfhi(wv[i]); yp[(size_t)i * LW] = (bf16)f2bf(h * __builtin_bit_cast(float, gv[i] << 16)); }
}
using pg8::Unit; using pg8::BM; using pg8::HALF; using pg8::cvt_pk_bf16;
template <bool F8OUT  > struct EpiSwiglu {
    static constexpr bool PERM = true; bf16* H;
    __device__ __forceinline__ void operator()(const f32x4 (&acc)[2][2][4][2], const Unit& u, int wr, int wc, int fr, int fq) const {
        const int row0 = u.pm * BM + wr * 64 + fr, col0 = u.pn * 128 + wc * 32 + 8 * fq;
#pragma unroll
        for (int ai = 0; ai < 2; ++ai)
#pragma unroll
            for (int m = 0; m < 4; ++m) { const size_t eo = (size_t)(row0 + ai * HALF + m * 16) * DFF + col0;
                float h[8];
#pragma unroll
                for (int n = 0; n < 2; ++n)
#pragma unroll
                    for (int j = 0; j < 4; ++j) { const float g = acc[ai][0][m][n][j], up = acc[ai][1][m][n][j]; h[4 * n + j] = g * up * sigm(g); }
                if constexpr (F8OUT) {
                    int q0 = PK8(h[0] * 4.f, h[1] * 4.f, 0, false); q0 = PK8(h[2] * 4.f, h[3] * 4.f, q0, true);
                    int q1 = PK8(h[4] * 4.f, h[5] * 4.f, 0, false); q1 = PK8(h[6] * 4.f, h[7] * 4.f, q1, true);
                    v2u qq; qq.x = (unsigned)q0; qq.y = (unsigned)q1; *(v2u*)((unsigned char*)H + eo) = qq;
                } else {
                    v4u w; w.x = cvt_pk_bf16(h[0], h[1]); w.y = cvt_pk_bf16(h[2], h[3]); w.z = cvt_pk_bf16(h[4], h[5]); w.w = cvt_pk_bf16(h[6], h[7]);
                    *(v4u*)(H + eo) = w; } }
    }
};
struct EpiSwigluI8 {
    static constexpr bool PERM = true; unsigned char* H; const float* rs; const unsigned* cmax;
    __device__ __forceinline__ void operator()(const f32x4 (&acc)[2][2][4][2], const Unit& u, int wr, int wc, int fr, int fq) const {
        const int row0 = u.pm * BM + wr * 64 + fr, col0 = u.pn * 128 + wc * 32 + 8 * fq;
        float cg[8], cu[8];
        { const v4u a0 = *(const v4u*)(cmax + col0), a1 = *(const v4u*)(cmax + col0 + 4), b0 = *(const v4u*)(cmax + DFF + col0), b1 = *(const v4u*)(cmax + DFF + col0 + 4);
          const unsigned ga[8] = {a0.x, a0.y, a0.z, a0.w, a1.x, a1.y, a1.z, a1.w}, ua[8] = {b0.x, b0.y, b0.z, b0.w, b1.x, b1.y, b1.z, b1.w};
#pragma unroll
          for (int i = 0; i < 8; ++i) { cg[i] = __builtin_bit_cast(float, ga[i]) * (1.f / 127.f); cu[i] = __builtin_bit_cast(float, ua[i]) * (4.f / 127.f); } }
        float rsv[8];
#pragma unroll
        for (int q = 0; q < 8; ++q) rsv[q] = rs[row0 + (q >> 2) * HALF + (q & 3) * 16];
#pragma unroll
        for (int ai = 0; ai < 2; ++ai)
#pragma unroll
            for (int m = 0; m < 4; ++m) { const int row = row0 + ai * HALF + m * 16; const size_t eo = (size_t)row * DFF + col0;
                const float r = rsv[ai * 4 + m];
                float g[8], h[8], e[8];
#pragma unroll
                for (int n = 0; n < 2; ++n) { const f32x4 gv = __builtin_convertvector(__builtin_bit_cast(i32x4_t, acc[ai][0][m][n]), f32x4), uv = __builtin_convertvector(__builtin_bit_cast(i32x4_t, acc[ai][1][m][n]), f32x4);
#pragma unroll
                    for (int j = 0; j < 4; ++j) { g[4 * n + j] = gv[j] * (r * cg[4 * n + j]); h[4 * n + j] = uv[j] * (r * cu[4 * n + j]); } }
#pragma unroll
                for (int i = 0; i < 8; ++i) e[i] = __builtin_amdgcn_exp2f(g[i] * -1.4426950408889634f);
#pragma unroll
                for (int i = 0; i < 8; ++i) h[i] *= g[i];
#pragma unroll
                for (int i = 0; i < 8; ++i) e[i] = __builtin_amdgcn_rcpf(1.0f + e[i]);
#pragma unroll
                for (int i = 0; i < 8; ++i) h[i] *= e[i];
                int q0 = PK8(h[0], h[1], 0, false); q0 = PK8(h[2], h[3], q0, true);
                int q1 = PK8(h[4], h[5], 0, false); q1 = PK8(h[6], h[7], q1, true);
                v2u qq; qq.x = (unsigned)q0; qq.y = (unsigned)q1; *(v2u*)(H + eo) = qq;
                __builtin_amdgcn_sched_barrier(0); }
    }
};
template <int MODE  > struct EpiResid {
    static constexpr bool PERM = true; bf16* V; const bf16* R; const float* xp; const float* xs; const float* meta; float scale; float* slab;
    __device__ __forceinline__ void operator()(const f32x4 (&acc)[2][2][4][2], const Unit& u, int wr, int wc, int fr, int fq) const {
        if (u.slab >= 0) {
            float* sp = slab + (size_t)u.slab * 65536 + (size_t)(wr * 64 + fr) * 256 + wc * 32 + 8 * fq;
#pragma unroll
            for (int ai = 0; ai < 2; ++ai)
#pragma unroll
                for (int m = 0; m < 4; ++m)
#pragma unroll
                    for (int bj = 0; bj < 2; ++bj) { float* q = sp + (ai * HALF + m * 16) * 256 + bj * HALF; *(f32x4*)q = acc[ai][bj][m][0]; *(f32x4*)(q + 4) = acc[ai][bj][m][1]; }
            return;
        }
        const int row0 = u.pm * BM + wr * 64 + fr, col0 = u.pn * BM + wc * 32 + 8 * fq;
#pragma unroll
        for (int ai = 0; ai < 2; ++ai) {
            v4u rw[4][2]; f32x4 rf[4][2][2]; float mk[4];
#pragma unroll
            for (int m = 0; m < 4; ++m) { const int row = row0 + ai * HALF + m * 16; mk[m] = ALPHA;
                if (MODE == 1) {
#pragma unroll
                    for (int bj = 0; bj < 2; ++bj) rw[m][bj] = *(const v4u*)(R + (size_t)row * DM + col0 + bj * HALF);
                } else { const float* rp = x0_row(xp, xs, meta, row); const float* rq = rp ? rp : xp;
                    mk[m] = rp ? ALPHA : 0.f;
#pragma unroll
                    for (int bj = 0; bj < 2; ++bj) { rf[m][bj][0] = *(const f32x4*)(rq + col0 + bj * HALF); rf[m][bj][1] = *(const f32x4*)(rq + col0 + bj * HALF + 4); } } }
            __builtin_amdgcn_sched_barrier(0);
#pragma unroll
            for (int m = 0; m < 4; ++m) { const int row = row0 + ai * HALF + m * 16;
#pragma unroll
                for (int bj = 0; bj < 2; ++bj) { const size_t o = (size_t)row * DM + col0 + bj * HALF;
                    f32x4 r0, r1;
                    if (MODE == 1) { const v4u w = rw[m][bj]; r0 = (f32x4){bflo(w.x), bfhi(w.x), bflo(w.y), bfhi(w.y)}; r1 = (f32x4){bflo(w.z), bfhi(w.z), bflo(w.w), bfhi(w.w)}; }
                    else { r0 = rf[m][bj][0]; r1 = rf[m][bj][1]; }
                    const f32x4 v0 = r0 * mk[m] + acc[ai][bj][m][0] * scale, v1 = r1 * mk[m] + acc[ai][bj][m][1] * scale;
                    v4u w; w.x = cvt_pk_bf16(v0[0], v0[1]); w.y = cvt_pk_bf16(v0[2], v0[3]); w.z = cvt_pk_bf16(v1[0], v1[1]); w.w = cvt_pk_bf16(v1[2], v1[3]);
                    *(v4u*)(V + o) = w; } }
            __builtin_amdgcn_sched_barrier(0); }
    }
};
template <bool I8> struct EpiZ {
    static constexpr bool PERM = true; bf16* Z; const float* rs; const unsigned* cmax;
    __device__ __forceinline__ void operator()(const f32x4 (&acc)[2][2][4][2], const Unit& u, int wr, int wc, int fr, int fq) const {
        const int row0 = u.pm * BM + wr * 64 + fr, col0 = u.pn * BM + wc * 32 + 8 * fq; const bool gl = u.pn >= 24;
        float rsv[8]; f32x4 cs[2][2];
        if constexpr (I8) {
#pragma unroll
            for (int q = 0; q < 8; ++q) rsv[q] = rs[row0 + (q >> 2) * HALF + (q & 3) * 16] * (1.f / 127.f);
#pragma unroll
            for (int bj = 0; bj < 2; ++bj) { cs[bj][0] = __builtin_bit_cast(f32x4, *(const v4u*)(cmax + col0 + bj * HALF)); cs[bj][1] = __builtin_bit_cast(f32x4, *(const v4u*)(cmax + col0 + bj * HALF + 4)); } }
#pragma unroll
        for (int ai = 0; ai < 2; ++ai)
#pragma unroll
            for (int m = 0; m < 4; ++m) { bf16* rowp = Z + (size_t)(row0 + ai * HALF + m * 16) * INW + col0;
#pragma unroll
                for (int bj = 0; bj < 2; ++bj) { f32x4 v0 = acc[ai][bj][m][0], v1 = acc[ai][bj][m][1];
                    if constexpr (I8) { const float r = rsv[ai * 4 + m];
                        v0 = __builtin_convertvector(__builtin_bit_cast(i32x4_t, acc[ai][bj][m][0]), f32x4) * (cs[bj][0] * r); v1 = __builtin_convertvector(__builtin_bit_cast(i32x4_t, acc[ai][bj][m][1]), f32x4) * (cs[bj][1] * r); }
                    if (gl) {
                        float xs[8] = {v0[0], v0[1], v0[2], v0[3], v1[0], v1[1], v1[2], v1[3]}, sg[8];
#pragma unroll
                        for (int i = 0; i < 8; ++i) sg[i] = xs[i] * (-2.302208198144325f + -0.1029432395800235f * (xs[i] * xs[i]));
#pragma unroll
                        for (int i = 0; i < 8; ++i) sg[i] = __builtin_amdgcn_exp2f(sg[i]);
#pragma unroll
                        for (int i = 0; i < 8; ++i) sg[i] = 1.0f + sg[i];
#pragma unroll
                        for (int i = 0; i < 8; ++i) sg[i] = __builtin_amdgcn_rcpf(sg[i]);
#pragma unroll
                        for (int j = 0; j < 4; ++j) { v0[j] = xs[j] * sg[j]; v1[j] = xs[4 + j] * sg[4 + j]; } }
                    v4u w; w.x = cvt_pk_bf16(v0[0], v0[1]); w.y = cvt_pk_bf16(v0[2], v0[3]); w.z = cvt_pk_bf16(v1[0], v1[1]); w.w = cvt_pk_bf16(v1[2], v1[3]);
                    *(v4u*)(rowp + bj * HALF) = w; } }
    }
};
struct EpiGate {
    static constexpr bool PERM = true; bf16* Gt; const float* bg; const float* rs; const unsigned* cmax;
    __device__ __forceinline__ void operator()(const f32x4 (&acc)[2][2][4][2], const Unit& u, int wr, int wc, int fr, int fq) const {
        const int row0 = u.pm * BM + wr * 64 + fr, col0 = u.pn * BM + wc * 32 + 8 * fq;
        float rsv[8]; f32x4 cs[2][2], bs[2][2];
#pragma unroll
        for (int q = 0; q < 8; ++q) rsv[q] = rs[row0 + (q >> 2) * HALF + (q & 3) * 16];
#pragma unroll
        for (int bj = 0; bj < 2; ++bj) { cs[bj][0] = __builtin_bit_cast(f32x4, *(const v4u*)(cmax + col0 + bj * HALF)); cs[bj][1] = __builtin_bit_cast(f32x4, *(const v4u*)(cmax + col0 + bj * HALF + 4));
            bs[bj][0] = *(const f32x4*)(bg + col0 + bj * HALF); bs[bj][1] = *(const f32x4*)(bg + col0 + bj * HALF + 4); }
        __builtin_amdgcn_sched_barrier(0);
#pragma unroll
        for (int bj = 0; bj < 2; ++bj) { cs[bj][0] = cs[bj][0] * (-1.4426950408889634f / 127.f); cs[bj][1] = cs[bj][1] * (-1.4426950408889634f / 127.f); bs[bj][0] = bs[bj][0] * -1.4426950408889634f; bs[bj][1] = bs[bj][1] * -1.4426950408889634f; }
#pragma unroll
        for (int ai = 0; ai < 2; ++ai)
#pragma unroll
            for (int m = 0; m < 4; ++m) { bf16* rowp = Gt + (size_t)(row0 + ai * HALF + m * 16) * NGATE + col0; const float r = rsv[ai * 4 + m];
#pragma unroll
                for (int bj = 0; bj < 2; ++bj) {
                    const i32x4_t i0 = __builtin_bit_cast(i32x4_t, acc[ai][bj][m][0]), i1 = __builtin_bit_cast(i32x4_t, acc[ai][bj][m][1]);
                    f32x4 v0 = __builtin_convertvector(i0, f32x4) * (cs[bj][0] * r) + bs[bj][0], v1 = __builtin_convertvector(i1, f32x4) * (cs[bj][1] * r) + bs[bj][1];
                    float sg[8] = {v0[0], v0[1], v0[2], v0[3], v1[0], v1[1], v1[2], v1[3]};
#pragma unroll
                    for (int i = 0; i < 8; ++i) sg[i] = __builtin_amdgcn_exp2f(sg[i]);
#pragma unroll
                    for (int i = 0; i < 8; ++i) sg[i] = 1.0f + sg[i];
#pragma unroll
                    for (int i = 0; i < 8; ++i) sg[i] = __builtin_amdgcn_rcpf(sg[i]);
                    v4u w; w.x = cvt_pk_bf16(sg[0], sg[1]); w.y = cvt_pk_bf16(sg[2], sg[3]); w.z = cvt_pk_bf16(sg[4], sg[5]); w.w = cvt_pk_bf16(sg[6], sg[7]);
                    *(v4u*)(rowp + bj * HALF) = w; }
                __builtin_amdgcn_sched_barrier(0); }
    }
};
struct EpiPool {
    static constexpr bool PERM = true; bf16* YA; const float* ps;
    __device__ __forceinline__ void operator()(const f32x4 (&acc)[2][2][4][2], const Unit& u, int wr, int wc, int fr, int fq) const {
        const int row0 = u.pm * BM + wr * 64 + fr, col0 = u.pn * BM + wc * 32 + 8 * fq;
        f32x4 sv[2][2];
#pragma unroll
        for (int bj = 0; bj < 2; ++bj)
#pragma unroll
            for (int n = 0; n < 2; ++n) sv[bj][n] = *(const f32x4*)(ps + col0 + bj * HALF + 4 * n);
#pragma unroll
        for (int ai = 0; ai < 2; ++ai)
#pragma unroll
            for (int m = 0; m < 4; ++m) { bf16* rowp = YA + (size_t)(row0 + ai * HALF + m * 16) * PW + col0;
#pragma unroll
                for (int bj = 0; bj < 2; ++bj) { const f32x4 v0 = acc[ai][bj][m][0] * sv[bj][0], v1 = acc[ai][bj][m][1] * sv[bj][1];
                    v4u w; w.x = cvt_pk_bf16(v0[0], v0[1]); w.y = cvt_pk_bf16(v0[2], v0[3]); w.z = cvt_pk_bf16(v1[0], v1[1]); w.w = cvt_pk_bf16(v1[2], v1[3]);
                    *(v4u*)(rowp + bj * HALF) = w; } }
    }
};
struct EpiLru {
    static constexpr bool PERM = true; unsigned* AB; const bf16* XC; const float* ba; const float* bxb; const float* cvp;
    __device__ __forceinline__ void operator()(const f32x4 (&acc)[2][2][4][2], const Unit& u, int wr, int wc, int fr, int fq) const {
        const int row0 = u.pm * BM + wr * 64 + fr, ch0 = u.pn * 128 + wc * 32 + 8 * fq;
        f32x4 bav[2], bxv[2], cv[2];
#pragma unroll
        for (int n = 0; n < 2; ++n) { bav[n] = *(const f32x4*)(ba + ch0 + 4 * n); bxv[n] = *(const f32x4*)(bxb + ch0 + 4 * n); cv[n] = *(const f32x4*)(cvp + ch0 + 4 * n); }
        v4u xwv[8];
#pragma unroll
        for (int q = 0; q < 8; ++q) xwv[q] = *(const v4u*)(XC + (size_t)(row0 + (q >> 2) * HALF + (q & 3) * 16) * LW + ch0);
        __builtin_amdgcn_sched_barrier(0);
#pragma unroll
        for (int ai = 0; ai < 2; ++ai)
#pragma unroll
            for (int m = 0; m < 4; ++m) { const size_t ro = (size_t)(row0 + ai * HALF + m * 16) * LW + ch0;
                const v4u xw = xwv[ai * 4 + m];
#pragma unroll
                for (int n = 0; n < 2; ++n) { const unsigned w0 = n ? xw.z : xw.x, w1 = n ? xw.w : xw.y;
                    const f32x4 xv = (f32x4){bflo(w0), bfhi(w0), bflo(w1), bfhi(w1)};
                    v4u pw;
                    float sg[8], la[4], aa[4];
#pragma unroll
                    for (int j = 0; j < 4; ++j) { sg[j] = acc[ai][0][m][n][j] + bav[n][j]; sg[4 + j] = acc[ai][1][m][n][j] + bxv[n][j]; }
                    sigmN<8>(sg);
#pragma unroll
                    for (int j = 0; j < 4; ++j) la[j] = cv[n][j] * sg[j];
#pragma unroll
                    for (int j = 0; j < 4; ++j) aa[j] = __builtin_amdgcn_exp2f(la[j] * 1.4426950408889634f);
#pragma unroll
                    for (int j = 0; j < 4; ++j) aa[j] = fmaxf(1.0f - aa[j] * aa[j], 0.0f);
#pragma unroll
                    for (int j = 0; j < 4; ++j) aa[j] = __builtin_amdgcn_sqrtf(aa[j]);
#pragma unroll
                    for (int j = 0; j < 4; ++j) pw[j] = cvt_pk_bf16(la[j], aa[j] * (sg[4 + j] * xv[j]));
                    *(v4u*)(AB + ro + 4 * n) = pw; }
                __builtin_amdgcn_sched_barrier(0); }
    }
};
struct EpiUpPool {
    static constexpr bool PERM = true; bf16* MP; const bf16* Gt; float* slab;
    __device__ __forceinline__ void operator()(const f32x4 (&acc)[2][2][4][2], const Unit& u, int wr, int wc, int fr, int fq) const {
        const int row0 = u.pm * BM + wr * 64 + fr, col0 = u.pn * BM + wc * 32 + 8 * fq;
        float* sp = slab + (size_t)(u.slab >= 0 ? u.slab : 0) * 65536 + (size_t)(wr * 64 + fr) * 256 + wc * 32 + 8 * fq;
#pragma unroll
        for (int ai = 0; ai < 2; ++ai) {
            v4u gwv[4][2];
#pragma unroll
            for (int m = 0; m < 4; ++m)
#pragma unroll
                for (int bj = 0; bj < 2; ++bj) gwv[m][bj] = *(const v4u*)(Gt + (size_t)(row0 + ai * HALF + m * 16) * NGATE + col0 + bj * HALF);
            __builtin_amdgcn_sched_barrier(0);
#pragma unroll
            for (int m = 0; m < 4; ++m) { const int row = row0 + ai * HALF + m * 16;
#pragma unroll
                for (int bj = 0; bj < 2; ++bj) { const v4u gw = gwv[m][bj];
                    const f32x4 g0 = (f32x4){bflo(gw.x), bfhi(gw.x), bflo(gw.y), bfhi(gw.y)}, g1 = (f32x4){bflo(gw.z), bfhi(gw.z), bflo(gw.w), bfhi(gw.w)};
                    const f32x4 v0 = acc[ai][bj][m][0] * g0, v1 = acc[ai][bj][m][1] * g1;
                    if (u.slab >= 0) {
                        float* q = sp + (ai * HALF + m * 16) * 256 + bj * HALF; *(f32x4*)q = v0; *(f32x4*)(q + 4) = v1;
                    } else { v4u w; w.x = cvt_pk_bf16(v0[0], v0[1]); w.y = cvt_pk_bf16(v0[2], v0[3]); w.z = cvt_pk_bf16(v1[0], v1[1]); w.w = cvt_pk_bf16(v1[2], v1[3]);
                        *(v4u*)(MP + (size_t)row * DM + col0 + bj * HALF) = w; } } }
            __builtin_amdgcn_sched_barrier(0); }
    }
};
struct EpiUpLru {
    static constexpr bool PERM = true; bf16* Mb; const bf16* MP; const bf16* Gt; float* slab; const float* slab8;
    __device__ __forceinline__ void operator()(const f32x4 (&acc)[2][2][4][2], const Unit& u, int wr, int wc, int fr, int fq) const {
        const int row0 = u.pm * BM + wr * 64 + fr, col0 = u.pn * BM + wc * 32 + 8 * fq;
        if (u.slab >= 0) {
            float* sp = slab + (size_t)u.slab * 65536 + (size_t)(wr * 64 + fr) * 256 + wc * 32 + 8 * fq;
#pragma unroll
            for (int h = 0; h < 4; ++h) {
                v4u gwv[2][2]; f32x4 pv[2][2][2];
#pragma unroll
                for (int mm = 0; mm < 2; ++mm) { const int ai = h >> 1, m = 2 * (h & 1) + mm, row = row0 + ai * HALF + m * 16;
#pragma unroll
                    for (int bj = 0; bj < 2; ++bj) { gwv[mm][bj] = *(const v4u*)(Gt + (size_t)row * NGATE + DM + col0 + bj * HALF);
                        const float* q8p = slab8 + (size_t)u.slab * 65536 + (size_t)(wr * 64 + fr) * 256 + wc * 32 + 8 * fq + (ai * HALF + m * 16) * 256 + bj * HALF;
                        pv[mm][bj][0] = __builtin_nontemporal_load((const f32x4*)q8p); pv[mm][bj][1] = __builtin_nontemporal_load((const f32x4*)(q8p + 4)); } }
                __builtin_amdgcn_sched_barrier(0);
#pragma unroll
                for (int mm = 0; mm < 2; ++mm) { const int ai = h >> 1, m = 2 * (h & 1) + mm;
#pragma unroll
                    for (int bj = 0; bj < 2; ++bj) { const v4u gw = gwv[mm][bj];
                        const f32x4 g0 = (f32x4){bflo(gw.x), bfhi(gw.x), bflo(gw.y), bfhi(gw.y)}, g1 = (f32x4){bflo(gw.z), bfhi(gw.z), bflo(gw.w), bfhi(gw.w)};
                        float* q = sp + (ai * HALF + m * 16) * 256 + bj * HALF;
                        *(f32x4*)q = pv[mm][bj][0] + acc[ai][bj][m][0] * g0; *(f32x4*)(q + 4) = pv[mm][bj][1] + acc[ai][bj][m][1] * g1; } }
                __builtin_amdgcn_sched_barrier(0); }
            return;
        }
#pragma unroll
        for (int ai = 0; ai < 2; ++ai) {
            v4u gwv[4][2], mwv[4][2];
#pragma unroll
            for (int m = 0; m < 4; ++m) { const int row = row0 + ai * HALF + m * 16;
#pragma unroll
                for (int bj = 0; bj < 2; ++bj) { gwv[m][bj] = *(const v4u*)(Gt + (size_t)row * NGATE + DM + col0 + bj * HALF);
                    mwv[m][bj] = __builtin_nontemporal_load((const v4u*)(MP + (size_t)row * DM + col0 + bj * HALF)); } }
            __builtin_amdgcn_sched_barrier(0);
#pragma unroll
            for (int m = 0; m < 4; ++m) { const int row = row0 + ai * HALF + m * 16;
#pragma unroll
                for (int bj = 0; bj < 2; ++bj) { const v4u gw = gwv[m][bj], mw = mwv[m][bj];
                    const f32x4 g0 = (f32x4){bflo(gw.x), bfhi(gw.x), bflo(gw.y), bfhi(gw.y)}, g1 = (f32x4){bflo(gw.z), bfhi(gw.z), bflo(gw.w), bfhi(gw.w)};
                    const f32x4 v0 = (f32x4){bflo(mw.x), bfhi(mw.x), bflo(mw.y), bfhi(mw.y)} + acc[ai][bj][m][0] * g0, v1 = (f32x4){bflo(mw.z), bfhi(mw.z), bflo(mw.w), bfhi(mw.w)} + acc[ai][bj][m][1] * g1;
                    v4u w; w.x = cvt_pk_bf16(v0[0], v0[1]); w.y = cvt_pk_bf16(v0[2], v0[3]); w.z = cvt_pk_bf16(v1[0], v1[1]); w.w = cvt_pk_bf16(v1[2], v1[3]);
                    *(v4u*)(Mb + (size_t)row * DM + col0 + bj * HALF) = w; } }
            __builtin_amdgcn_sched_barrier(0); }
    }
};

template <int MODE, bool QC = false> __device__ __forceinline__ void ln_finish(f32x4 (&v)[16], const f32x4 (&gv)[16], const f32x4 (&bv)[16], float* dst, bf16* xbrow, unsigned char* q8row, float* rsrow, int lane) {
    float s = 0.f;
#pragma unroll
    for (int j = 0; j < 16; ++j) s += (v[j].x + v[j].y) + (v[j].z + v[j].w);
    const float mean = wave_sum(s) * (1.f / DM); float s2 = 0.f;
#pragma unroll
    for (int j = 0; j < 16; ++j) { v[j] = v[j] - mean; s2 += (v[j].x * v[j].x + v[j].y * v[j].y) + (v[j].z * v[j].z + v[j].w * v[j].w); }
    const float rstd = 1.f / sqrtf(wave_sum(s2) * (1.f / DM) + LN_EPS);
    float mx = 0.f;
#pragma unroll
    for (int c = 0; c < 8; ++c) { const int o = 8 * lane + 512 * c;
        const f32x4 y0 = v[2 * c] * rstd * gv[2 * c] + bv[2 * c], y1 = v[2 * c + 1] * rstd * gv[2 * c + 1] + bv[2 * c + 1];
        if (MODE == 1) { *(f32x4*)(dst + o) = y0; *(f32x4*)(dst + o + 4) = y1; }
        if (MODE == 0) { v4u w; w.x = pg8::cvt_pk_bf16(y0.x, y0.y); w.y = pg8::cvt_pk_bf16(y0.z, y0.w); w.z = pg8::cvt_pk_bf16(y1.x, y1.y); w.w = pg8::cvt_pk_bf16(y1.z, y1.w); *(v4u*)(xbrow + o) = w;
            if (QC) { v[2 * c] = y0; v[2 * c + 1] = y1;
                mx = fmaxf(mx, fmaxf(fmaxf(fmaxf(fabsf(y0.x), fabsf(y0.y)), fmaxf(fabsf(y0.z), fabsf(y0.w))), fmaxf(fmaxf(fabsf(y1.x), fabsf(y1.y)), fmaxf(fabsf(y1.z), fabsf(y1.w))))); } } }
    if (MODE == 0 && QC) {
        mx = wave_max(mx); const float inv = mx > 0.f ? 127.f / mx : 0.f;
        if (lane == 0) *rsrow = mx * (1.f / 127.f);
#pragma unroll
        for (int c = 0; c < 8; ++c) { const f32x4 a = v[2 * c] * inv, b = v[2 * c + 1] * inv;
            v2u qq; qq.x = pack4(q8i(a.x), q8i(a.y), q8i(a.z), q8i(a.w)); qq.y = pack4(q8i(b.x), q8i(b.y), q8i(b.z), q8i(b.w)); *(v2u*)(q8row + 8 * lane + 512 * c) = qq; }
    }
}
template <int MODE> __device__ __forceinline__ float* ln_dst(int row, float* Xf, float* out) {
    if (MODE == 1) {
        if (row < MPROMPT) { const int b = row / TP, t = row - b * TP; if (t < NMETA) return nullptr; return out + O_YP + ((size_t)b * SEQ + (t - NMETA)) * DM; }
        return out + O_YS + (size_t)(row - MPROMPT) * DM;
    }
    return Xf;
}
template <int MODE, int RES, bool QC = false> __device__ __forceinline__ void ln_rows(bf16* V, const float* slab, const bf16* resbuf, const float* xp, const float* xs, const float* meta, float scale,
                                                                     const float* gam, const float* bet, float* Xf, bf16* Xb, float* out, int gw, int NGW, int lane, unsigned char* Xq = nullptr, float* Rs = nullptr) {
    const int nrows = MODE == 0 ? MPAD : MREAL;
    const int wv = gw & (NWAVES - 1), cu = gw / NWAVES, Gq = NGW / NWAVES, TPW = (MPAD - 8192 + Gq - 1) / Gq;
    for (int k = 0; k < TPW; ++k) { const int row = 8192 + cu * TPW + k; if (row >= nrows) break;
        asm volatile("" : "+v"(lane));
        const int pmi = (row - 8192) >> 8, rr = row & 255;
        const float* rp = RES == 1 ? nullptr : x0_row(xp, xs, meta, row);
#pragma unroll
        for (int jj = 0; jj < 2; ++jj) { const int j = wv + NWAVES * jj; const float* sp = slab + ((size_t)((pmi * 16 + j) * 8) * 256 + rr) * 256 + 4 * lane;
            f32x4 a = *(const f32x4*)sp;
#pragma unroll
            for (int ks = 1; ks < 8; ++ks) a += *(const f32x4*)(sp + (size_t)ks * 65536);
            f32x4 r = (f32x4){0.f, 0.f, 0.f, 0.f};
            if (RES == 1) { const v2u w = *(const v2u*)(resbuf + (size_t)row * DM + 4 * lane + 256 * j); r = (f32x4){bflo(w.x), bfhi(w.x), bflo(w.y), bfhi(w.y)}; } else if (rp) r = *(const f32x4*)(rp + 4 * lane + 256 * j);
            const f32x4 y = r * ALPHA + a * scale; v2u w; w.x = pg8::cvt_pk_bf16(y.x, y.y); w.y = pg8::cvt_pk_bf16(y.z, y.w);
            *(v2u*)(V + (size_t)row * DM + 4 * lane + 256 * j) = w; }
    }
    asm volatile("s_waitcnt vmcnt(0)" ::: "memory");
    __syncthreads();
    f32x4 gv[16], bv[16];
#pragma unroll
    for (int c = 0; c < 8; ++c) { const int o = 8 * lane + 512 * c; gv[2 * c] = *(const f32x4*)(gam + o); gv[2 * c + 1] = *(const f32x4*)(gam + o + 4); bv[2 * c] = *(const f32x4*)(bet + o); bv[2 * c + 1] = *(const f32x4*)(bet + o + 4); }
    const int nmain = gw < 8192 ? (8192 - gw + NGW - 1) / NGW : 0, ntail = wv < TPW ? (TPW - wv + NWAVES - 1) / NWAVES : 0;
    for (int it = 0; it < nmain + ntail; ++it) {
        const int row = it < nmain ? gw + it * NGW : 8192 + cu * TPW + wv + (it - nmain) * NWAVES;
        if (row >= nrows) break;
        float* dst = ln_dst<MODE>(row, Xf, out); if (!dst) continue;
        asm volatile("" : "+v"(lane));
        f32x4 v[16];
#pragma unroll
        for (int c = 0; c < 8; ++c) { const v4u w = __builtin_nontemporal_load((const v4u*)(V + (size_t)row * DM + 8 * lane + 512 * c));
            v[2 * c] = (f32x4){bflo(w.x), bfhi(w.x), bflo(w.y), bfhi(w.y)}; v[2 * c + 1] = (f32x4){bflo(w.z), bfhi(w.z), bflo(w.w), bfhi(w.w)}; }
        ln_finish<MODE, QC>(v, gv, bv, dst, Xb + (size_t)row * DM, QC ? Xq + (size_t)row * DM : nullptr, QC ? Rs + row : nullptr, lane);
    }
}

__host__ __device__ __forceinline__ int pg8_units(int n, int G, int w) { return n > w ? (n - 1 - w) / G + 1 : 0; }
struct Args { const float* in[31]; float* out; unsigned char* ws; int ph_lo, ph_hi, li, pad; };
__global__ void __launch_bounds__(NWAVES * 64, 2) mk_fwd(Args args) {
    extern __shared__ __attribute__((aligned(16))) unsigned char lds_raw[];
    LAS unsigned char* lds = (LAS unsigned char*)lds_raw;
    volatile LAS unsigned* MISC = (volatile LAS unsigned*)(lds + MISC_OFF);
    const int wave = __builtin_amdgcn_readfirstlane((int)threadIdx.x >> 6);
#define PHASE_IDS const int lane = lane_now(), tid = (wave << 6) | lane, gtid = vcu * (NWAVES * 64) + tid; (void)tid; (void)gtid
    const int G = gridDim.x; const int bx = blockIdx.x; const int vcu = (G % 8 == 0) ? (bx % 8) * (G / 8) + bx / 8 : bx;
    unsigned char* ws = args.ws;
    gu32* ctl = (gu32*)(ws + WS_CTL);
    const float* x_prompt = args.in[0]; const float* x_sample = args.in[1]; const float* state_pool = args.in[2]; const float* state_conv = args.in[3]; const float* state_lru = args.in[4];
    const float* meta = args.in[5];
    float* out = args.out;
    bf16* WMIX = (bf16*)(ws + WS_WMIX); bf16* WPOOL = (bf16*)(ws + WS_WPOOL); bf16* WLRU = (bf16*)(ws + WS_WLRU); bf16* WUPP = (bf16*)(ws + WS_WUPP); bf16* WUPL = (bf16*)(ws + WS_WUPL); bf16* WOUT = (bf16*)(ws + WS_WOUT);
    bf16* WFA = (bf16*)(ws + WS_WFA); bf16* WFB = (bf16*)(ws + WS_WFB);
    bf16* XB = (bf16*)(ws + WS_XB); bf16* HB = (bf16*)(ws + WS_H); unsigned* ABW = (unsigned*)(ws + WS_A); bf16* DB = (bf16*)(ws + WS_D);
    bf16* VB = (bf16*)(ws + WS_V); bf16* MPB = (bf16*)(ws + WS_MP); bf16* X1B = (bf16*)(ws + WS_X1F); unsigned char* X1Q8 = ws + WS_X1F + 68 * MiB;     unsigned char* WG8 = ws + WS_WMIX + (size_t)INW * DM * 2;
    bf16* ZB = (bf16*)(ws + WS_Z); bf16* MB = (bf16*)(ws + WS_MB); bf16* GT = (bf16*)(ws + WS_GATES); bf16* YA = (bf16*)(ws + WS_YA); bf16* YB = (bf16*)(ws + WS_YB); float* CVB = (float*)(ws + WS_CV); float* SLAB2 = (float*)(ws + WS_H);
    float* SLAB = (float*)(ws + WS_GATES);
    unsigned* CMAX1 = (unsigned*)(ws + WS_CMAX1); unsigned* CMAX2 = (unsigned*)(ws + WS_CMAX2); unsigned* CMAXG = (unsigned*)(ws + WS_CMAXG); unsigned* CMAXZ = (unsigned*)(ws + WS_CMAXZ); bf16* WZB = (bf16*)(ws + WS_WZB);
    float* RS0 = (float*)(ws + WS_RS0); float* RS1 = (float*)(ws + WS_RS1); float* RS2 = (float*)(ws + WS_RS2);
    unsigned char* XQ0 = ws + WS_XB;            unsigned char* X2Q = X1Q8;

    { const int tid0 = (wave << 6) | lane_now(); for (int u = tid0; u < (LDS_BYTES - LDSCTL_OFF) / 4; u += NWAVES * 64) ((LAS unsigned*)(lds + LDSCTL_OFF))[u] = 0u; }
    __syncthreads();
    XcdBarrier bar = xcd_barrier_post((unsigned*)(ctl + CW_BAR) + args.li * XCD_BAR_WORDS, MISC + 8, wave == 0 && lane_now() == 0);
#define GRID_BAR() xcd_barrier(bar, wave == 0 && lane_now() == 0)
    const int lo = args.ph_lo, hi = args.ph_hi;
#define IN(k) (lo <= (k) && (k) < hi)
#define BOTH(k) (IN(k) && IN((k) + 1))
    const int gw = vcu * NWAVES + wave, NGW = G * NWAVES;
    const int NT = G * NWAVES * 64;
    LAS unsigned* scr = (LAS unsigned*)(lds + RING_OFF + wave * 16384);

    if (IN(0)) { PHASE_IDS;
        { constexpr int C0 = 64 * 86, C1 = 64 * 86, C2 = 64 * 32, C3 = 64 * 40;
          for (int it = gw; it < C0 + C1 + C2 + C3; it += NGW) {
              if (it < C0) colmax_job<true>(args.in[6], 2 * DFF, CMAX1, it, lane);
              else if (it < C0 + C1) colmax_job<true>(args.in[27], 2 * DFF, CMAX2, it - C0, lane);
              else if (it < C0 + C1 + C2) colmax_job<false>(args.in[20], NGATE, CMAXG, it - C0 - C1, lane);
              else colmax_job<false>(args.in[10], INW, CMAXZ, it - C0 - C1 - C2, lane); } }
        GRID_BAR();
        constexpr int I0 = 32 * 344  , I2 = 32 * 160  , I3 = 32 * 128  , I4 = 4 * 64, I5 = 16 * 16, I6 = 16 * 16, I7 = 64 * 96  ;
        constexpr int NITEMS = I0 + I2 + I3 + I4 + I5 + I6 + I7;
        for (int it = gw; it < NITEMS; it += NGW) {
            int r = it;
            if (r < I2) { tr_job_i8(args.in[10], DM, INW, (unsigned char*)WMIX, 0, r, scr, lane, CMAXZ); continue; } r -= I2;
            if (r < I7) { const int kb = r / 96, nb = r - kb * 96; tr_item(args.in[10], INW, WZB, DM, 64 * kb, 64 * nb, 64 * nb, scr, lane); continue; } r -= I7;
            if (r < I3) { tr_job_i8(args.in[20], DM, NGATE, WG8, 0, r, scr, lane, CMAXG); continue; } r -= I3;
            if (r < I0) { tr_job_i8(args.in[6], DM, 2 * DFF, (unsigned char*)WFA, 1, r, scr, lane, CMAX1); continue; } r -= I0;
            if (r < I4) { const int g = r >> 6; tr_job(args.in[11] + (size_t)g * 512 * 512, 512, 512, WPOOL, 0, g * 512, r & 63, scr, lane); continue; } r -= I4;
            if (r < I5) { const int b = r >> 4; tr_job(args.in[15] + (size_t)b * 256 * 256, 256, 256, WLRU, 2, b * 512, r & 15, scr, lane); continue; } r -= I5;
            { const int b = r >> 4; tr_job(args.in[17] + (size_t)b * 256 * 256, 256, 256, WLRU, 2, b * 512 + 128, r & 15, scr, lane); }
        }
        for (int row = gw; row < MPAD; row += NGW) {
            const float* src = x0_row(x_prompt, x_sample, meta, row);
            f32x4 a[16]; float mx = 0.f;
#pragma unroll
            for (int j = 0; j < 8; ++j) { a[2 * j] = (f32x4){0.f, 0.f, 0.f, 0.f}; a[2 * j + 1] = a[2 * j];
                if (src) { a[2 * j] = *(const f32x4*)(src + 512 * j + 8 * lane); a[2 * j + 1] = *(const f32x4*)(src + 512 * j + 8 * lane + 4); } }
#pragma unroll
            for (int j = 0; j < 16; ++j) mx = fmaxf(mx, fmaxf(fmaxf(fabsf(a[j].x), fabsf(a[j].y)), fmaxf(fabsf(a[j].z), fabsf(a[j].w))));
            mx = wave_max(mx); const float inv = mx > 0.f ? 127.f / mx : 0.f;
            if (lane == 0) RS0[row] = mx * (1.f / 127.f);
#pragma unroll
            for (int j = 0; j < 8; ++j) { const f32x4 p = a[2 * j] * inv, q = a[2 * j + 1] * inv;
                v2u w; w.x = pack4(q8i(p.x), q8i(p.y), q8i(p.z), q8i(p.w)); w.y = pack4(q8i(q.x), q8i(q.y), q8i(q.z), q8i(q.w));
                *(v2u*)(XQ0 + (size_t)row * DM + 512 * j + 8 * lane) = w; }
        }
        for (int i = gtid; i < LW; i += NT) CVB[i] = -8.0f * log1pf(expf(-args.in[19][i]));
        if (BOTH(0)) GRID_BAR();
    }
#define TAIL_WGS(nun) (((nun) % G) == 0 ? G : G - ((nun) % G))
#define TAIL_RANK(nun) (((nun) % G) == 0 ? bx : bx - ((nun) % G))
    if (IN(1)) { PHASE_IDS;
        pg8::Gemm g{(const bf16*)XQ0, WFA, DM / 2, DM / 2, DM / 2, 1 << 20, 0}; pg8::StaticOrder S; S.init(MPAD, 2 * DFF, G, bx);
        EpiSwigluI8 E{(unsigned char*)HB, RS0, CMAX1};
        pg8::gemm_phase<EpiSwigluI8, pg8::StaticOrder, PG8_ALIGN, PG8_SP2, 2>(lds + RING_OFF, g, S, E, wave);
        { const int tr = TAIL_RANK(34 * 86), tn = TAIL_WGS(34 * 86);
          if (tr >= 0) for (int it = tr * NWAVES + wave; it < 86 * 64; it += tn * NWAVES) { const int kb = it >> 6, nb = it & 63; tr_item8(args.in[7], DM, (unsigned char*)WFB, DFF, 128 * kb, 64 * nb, 64 * nb, scr, lane, 128.f); } }
        if (BOTH(1)) GRID_BAR();
    }
    if (IN(2)) { PHASE_IDS;
        pg8::Gemm g{HB, WFB, DFF / 2, DFF / 2, DFF / 2, 1 << 20, 0}; pg8::SplitTailOrder S; S.init(DM, DFF / 128, G, bx);
        EpiResid<0> E{VB, nullptr, x_prompt, x_sample, meta, 0.5f / 512.f, SLAB};
        pg8::gemm_phase<EpiResid<0>, pg8::SplitTailOrder, PG8_ALIGN, PG8_SP2, true>(lds + RING_OFF, g, S, E, wave);
        if (BOTH(2)) GRID_BAR();
    }
    if (IN(3)) { PHASE_IDS;
        ln_rows<0, 0, true>(VB, SLAB, nullptr, x_prompt, x_sample, meta, 0.5f / 512.f, args.in[8], args.in[9], out, X1B, nullptr, gw, NGW, lane, X1Q8, RS1);
        for (int it = gw; it < 32 * 344; it += NGW) tr_job_i8(args.in[27], DM, 2 * DFF, (unsigned char*)WFA, 1, it, scr, lane, CMAX2);
        if (BOTH(3)) GRID_BAR();
    }
    if (IN(4)) { PHASE_IDS;
        constexpr int NZ8 = 34 * 16 + 29 * 24, NZB = 5 * 24, NGT = 34 * 32;
        const int c8 = bx, cb = ((bx - NZ8) % G + G) % G, cg = ((bx - NZ8 - NZB) % G + G) % G;
        { pg8::Gemm g{(const bf16*)X1Q8, WMIX, DM / 2, DM / 2, DM / 2, 1 << 20, 0}; pg8::Z8Order S; S.init(G, c8);
          EpiZ<true> E{ZB, RS1, CMAXZ};
          pg8::gemm_phase<EpiZ<true>, pg8::Z8Order, PG8_ALIGN, PG8_SP2, 2>(lds + RING_OFF, g, S, E, wave); }
        { pg8::Gemm g{X1B, WZB, DM, DM, DM, 1 << 20, 0}; pg8::ZbOrder S; S.init(G, cb);
          EpiZ<false> E{ZB, nullptr, nullptr};
          pg8::gemm_phase<EpiZ<false>, pg8::ZbOrder, PG8_ALIGN, PG8_SP2>(lds + RING_OFF, g, S, E, wave); }
        { pg8::Gemm g{(const bf16*)X1Q8, (const bf16*)WG8, DM / 2, DM / 2, DM / 2, 1 << 20, 0}; pg8::StaticOrder S; S.init(MPAD, NGATE, G, cg);
          EpiGate E{GT, args.in[21], RS1, CMAXG};
          pg8::gemm_phase<EpiGate, pg8::StaticOrder, PG8_ALIGN, PG8_SP2, 2>(lds + RING_OFF, g, S, E, wave); }
        {
          const bool conv = G == 256 && bx >= 80; const int tn = G == 256 ? 248 : 0;
          const int s0 = bx < 144 ? bx - 80 : (bx < 216 ? 64 + 2 * (bx - 144) : 208 + (bx - 216)), ns = (bx >= 144 && bx < 216) ? 2 : 1;
          const int lane = lane_now();
          if (tn > 0 && conv) for (int sl = s0; sl < s0 + ns; ++sl) for (int it = sl * NWAVES + wave; it < 32 * 64 + 2 * 64 * 64; it += tn * NWAVES) {
              if (it < 32 * 64) tr_job(args.in[22], PW, DM, WUPP, 0, 0, it, scr, lane);
              else if (it < 32 * 64 + 64 * 64) tr_job(args.in[23], LW, DM, WUPL, 0, 0, it - 32 * 64, scr, lane);
              else tr_job(args.in[24], DM, DM, WOUT, 0, 0, it - 32 * 64 - 64 * 64, scr, lane); }
          else if (tn <= 0) for (int it = gw; it < 32 * 64 + 2 * 64 * 64; it += NGW) {
              if (it < 32 * 64) tr_job(args.in[22], PW, DM, WUPP, 0, 0, it, scr, lane);
              else if (it < 32 * 64 + 64 * 64) tr_job(args.in[23], LW, DM, WUPL, 0, 0, it - 32 * 64, scr, lane);
              else tr_job(args.in[24], DM, DM, WOUT, 0, 0, it - 32 * 64 - 64 * 64, scr, lane); } }
        if (BOTH(4)) GRID_BAR();
    }
    if (IN(5)) { PHASE_IDS;
        for (int i = gtid; i < 4 * 86 * 256 + 8 * 2 * 256; i += NT) {
            int v, t0, R, rowbase, nh; const float* hist = nullptr;
            if (i < 4 * 86 * 256) { v = i & 255; const int q = i >> 8, seq = q / 86; t0 = (q - seq * 86) * 24; R = 24; rowbase = seq * TP; nh = 0; }
            else { const int j = i - 4 * 86 * 256; v = j & 255; const int q = j >> 8, sb = q >> 1; t0 = (q & 1) * 16; R = 16; rowbase = MPROMPT + sb * TS; nh = 15; hist = state_pool + (size_t)sb * 15 * PW; }
            const int c0 = v * 8, w = 2 << (v >> 6);
            const bf16* zp = ZB + (size_t)rowbase * INW + c0;
            float s[8];
#pragma unroll
            for (int e = 0; e < 8; ++e) s[e] = 0.f;
            for (int k = 1; k < w; ++k) { const int tt = t0 - k;
                if (tt >= 0) { const v4u zw = *(const v4u*)(zp + (size_t)tt * INW);
                    s[0] += bflo(zw.x); s[1] += bfhi(zw.x); s[2] += bflo(zw.y); s[3] += bfhi(zw.y); s[4] += bflo(zw.z); s[5] += bfhi(zw.z); s[6] += bflo(zw.w); s[7] += bfhi(zw.w); }
                else if (hist) { const float* hp = hist + (size_t)(15 + tt) * PW + c0; const f32x4 a = *(const f32x4*)hp, b = *(const f32x4*)(hp + 4);
                    s[0] += a.x; s[1] += a.y; s[2] += a.z; s[3] += a.w; s[4] += b.x; s[5] += b.y; s[6] += b.z; s[7] += b.w; } }
            for (int r = 0; r < R; ++r) { const int t = t0 + r;
                const v4u zw = *(const v4u*)(zp + (size_t)t * INW);
                const float cur[8] = {bflo(zw.x), bfhi(zw.x), bflo(zw.y), bfhi(zw.y), bflo(zw.z), bfhi(zw.z), bflo(zw.w), bfhi(zw.w)};
                const int cnt = (nh + 1 + t) < w ? (nh + 1 + t) : w; const float inv = 1.0f / (float)cnt;
                float d[8];
#pragma unroll
                for (int e = 0; e < 8; ++e) { s[e] += cur[e]; d[e] = s[e] * inv - cur[e]; }
                v4u o; o.x = pk2(d[0], d[1]); o.y = pk2(d[2], d[3]); o.z = pk2(d[4], d[5]); o.w = pk2(d[6], d[7]);
                *(v4u*)(DB + (size_t)(rowbase + t) * PW + c0) = o;
                const int tt = t - w + 1;
                if (tt >= 0) { const v4u ow = *(const v4u*)(zp + (size_t)tt * INW);
                    s[0] -= bflo(ow.x); s[1] -= bfhi(ow.x); s[2] -= bflo(ow.y); s[3] -= bfhi(ow.y); s[4] -= bflo(ow.z); s[5] -= bfhi(ow.z); s[6] -= bflo(ow.w); s[7] -= bfhi(ow.w); }
                else if (hist) { const float* hp = hist + (size_t)(15 + tt) * PW + c0; const f32x4 a = *(const f32x4*)hp, b = *(const f32x4*)(hp + 4);
                    s[0] -= a.x; s[1] -= a.y; s[2] -= a.z; s[3] -= a.w; s[4] -= b.x; s[5] -= b.y; s[6] -= b.z; s[7] -= b.w; } }
        }
        const float* conv_w = args.in[13]; const float* conv_b = args.in[14];
        for (int i = gtid; i < 4 * 48 * 512 + 8 * 2 * 512; i += NT) {
            int v, t0, R, rowbase; const float* hist = nullptr;
            if (i < 4 * 48 * 512) { v = i & 511; const int q = i >> 9, seq = q / 48; t0 = (q - seq * 48) * 43; R = 43; rowbase = seq * TP; }
            else { const int j = i - 4 * 48 * 512; v = j & 511; const int q = j >> 9, sb = q >> 1; t0 = (q & 1) * 16; R = 16; rowbase = MPROMPT + sb * TS; hist = state_conv + (size_t)sb * 3 * LW; }
            const int c0 = v * 8;
            const bf16* zp = ZB + (size_t)rowbase * INW + PW + c0;
            float wk[4][8], bb[8], zh[3][8];
#pragma unroll
            for (int k = 0; k < 4; ++k) { const f32x4 w0 = *(const f32x4*)(conv_w + (size_t)k * LW + c0), w1 = *(const f32x4*)(conv_w + (size_t)k * LW + c0 + 4);
                wk[k][0] = w0.x; wk[k][1] = w0.y; wk[k][2] = w0.z; wk[k][3] = w0.w; wk[k][4] = w1.x; wk[k][5] = w1.y; wk[k][6] = w1.z; wk[k][7] = w1.w; }
            { const f32x4 b0 = *(const f32x4*)(conv_b + c0), b1 = *(const f32x4*)(conv_b + c0 + 4); bb[0] = b0.x; bb[1] = b0.y; bb[2] = b0.z; bb[3] = b0.w; bb[4] = b1.x; bb[5] = b1.y; bb[6] = b1.z; bb[7] = b1.w; }
#pragma unroll
            for (int k = 0; k < 3; ++k) { const int tt = t0 - 3 + k;
#pragma unroll
                for (int e = 0; e < 8; ++e) zh[k][e] = 0.f;
                if (tt >= 0) { const v4u zw = *(const v4u*)(zp + (size_t)tt * INW);
                    zh[k][0] = bflo(zw.x); zh[k][1] = bfhi(zw.x); zh[k][2] = bflo(zw.y); zh[k][3] = bfhi(zw.y); zh[k][4] = bflo(zw.z); zh[k][5] = bfhi(zw.z); zh[k][6] = bflo(zw.w); zh[k][7] = bfhi(zw.w); }
                else if (hist) { const float* hp = hist + (size_t)(3 + tt) * LW + c0; const f32x4 h0 = *(const f32x4*)hp, h1 = *(const f32x4*)(hp + 4);
                    zh[k][0] = h0.x; zh[k][1] = h0.y; zh[k][2] = h0.z; zh[k][3] = h0.w; zh[k][4] = h1.x; zh[k][5] = h1.y; zh[k][6] = h1.z; zh[k][7] = h1.w; } }
            for (int r = 0; r < R; ++r) { const int t = t0 + r;
                const v4u zw = *(const v4u*)(zp + (size_t)t * INW);
                const float cur[8] = {bflo(zw.x), bfhi(zw.x), bflo(zw.y), bfhi(zw.y), bflo(zw.z), bfhi(zw.z), bflo(zw.w), bfhi(zw.w)};
                float a[8];
#pragma unroll
                for (int e = 0; e < 8; ++e) { a[e] = bb[e] + zh[0][e] * wk[0][e] + zh[1][e] * wk[1][e] + zh[2][e] * wk[2][e] + cur[e] * wk[3][e]; zh[0][e] = zh[1][e]; zh[1][e] = zh[2][e]; zh[2][e] = cur[e]; }
                v4u o; o.x = pk2(a[0], a[1]); o.y = pk2(a[2], a[3]); o.z = pk2(a[4], a[5]); o.w = pk2(a[6], a[7]);
                *(v4u*)(XB + (size_t)(rowbase + t) * LW + c0) = o; }
        }
        for (int i = gtid; i < NBP * 15 * PW; i += NT) { const int c = i % PW, j = (i / PW) % 15, b = i / (15 * PW); out[O_PP + i] = __builtin_bit_cast(float, (unsigned)ZB[(size_t)(b * TP + TP - 15 + j) * INW + c] << 16); }
        for (int i = gtid; i < NBP * 3 * LW; i += NT) { const int c = i % LW, j = (i / LW) % 3, b = i / (3 * LW); out[O_CP + i] = __builtin_bit_cast(float, (unsigned)ZB[(size_t)(b * TP + TP - 3 + j) * INW + PW + c] << 16); }
        for (int i = gtid; i < NBS * 15 * PW; i += NT) { const int c = i % PW, j = (i / PW) % 15, b = i / (15 * PW); out[O_PS + i] = __builtin_bit_cast(float, (unsigned)ZB[(size_t)(MPROMPT + b * TS + TS - 15 + j) * INW + c] << 16); }
        for (int i = gtid; i < NBS * 3 * LW; i += NT) { const int c = i % LW, j = (i / LW) % 3, b = i / (3 * LW); out[O_CS + i] = __builtin_bit_cast(float, (unsigned)ZB[(size_t)(MPROMPT + b * TS + TS - 3 + j) * INW + PW + c] << 16); }
        if (BOTH(5)) GRID_BAR();
    }
    if (IN(6)) { PHASE_IDS;
        { pg8::Gemm g{DB, WPOOL, PW, 512, 512, 2, 512}; pg8::StaticOrder S; S.init(MPAD, PW, G, bx);
          EpiPool E{YA, args.in[12]};
          pg8::gemm_phase<EpiPool, pg8::StaticOrder, PG8_ALIGN, PG8_SP2>(lds + RING_OFF, g, S, E, wave); }
        { pg8::Gemm g{XB, WLRU, LW, 256, 256, 2, 256}; pg8::StaticOrder S; S.init(MPAD, 2 * LW, G, G - 1 - bx);
          EpiLru E{ABW, XB, args.in[16], args.in[18], CVB};
          pg8::gemm_phase<EpiLru, pg8::StaticOrder, PG8_ALIGN, PG8_SP2>(lds + RING_OFF, g, S, E, wave); }
        if (BOTH(6)) GRID_BAR();
    }
    if (IN(7)) { PHASE_IDS;
        LAS float* cs = (LAS float*)(lds + RING_OFF);
        for (int item = bx; item < NBP * 64; item += G) {
            const int seq = item >> 6, ch = (item & 63) * 64 + lane, c = wave;
            const size_t r0 = (size_t)seq * TP + (size_t)c * 258;
            const unsigned* ap = ABW + r0 * LW + ch;
            float h = 0.f, S = 0.f;
            for (int s = 0; s < 240; s += 24) scan_blk1<24>(ap + (size_t)s * LW, h, S);
            scan_blk1<18>(ap + (size_t)240 * LW, h, S);
            cs[(c * 64 + lane) * 2] = __expf(S); cs[(c * 64 + lane) * 2 + 1] = h;
            __syncthreads();
            float hc = 0.f;
            for (int k = 0; k < c; ++k) hc = cs[(k * 64 + lane) * 2] * hc + cs[(k * 64 + lane) * 2 + 1];
            __syncthreads();
            h = hc;
            const bf16* gp = ZB + r0 * INW + (PW + LW) + ch; bf16* yp = YB + r0 * LW + ch;
            for (int s = 0; s < 256; s += 16) scan_blk3<16>(ap + (size_t)s * LW, gp + (size_t)s * INW, yp + (size_t)s * LW, h);
            scan_blk3<2>(ap + (size_t)256 * LW, gp + (size_t)256 * INW, yp + (size_t)256 * LW, h);
            if (c == 7) out[O_LP + (size_t)seq * LW + ch] = h;
        }
        for (int base = bx * 128; base < NBS * LW; base += G * 128) {
            if (tid < 128) { const int idx = base + tid, sb = idx >> 12, ch = idx & 4095;
                float h = state_lru[idx];
                const size_t r0 = (size_t)MPROMPT + (size_t)sb * TS;
                for (int s = 0; s < TS; s += 16) scan_blk3<16>(ABW + (r0 + s) * LW + ch, ZB + (r0 + s) * INW + (PW + LW) + ch, YB + (r0 + s) * LW + ch, h);
                out[O_LS + idx] = h; }
        }
        if (BOTH(7)) GRID_BAR();
    }
    if (IN(8)) { PHASE_IDS;
        pg8::Gemm g{YA, WUPP, PW, PW, PW, 1 << 20, 0}; pg8::SplitTailOrder S; S.init(DM, PW / 64, G, bx);
        EpiUpPool E{MPB, GT, SLAB2};
        pg8::gemm_phase<EpiUpPool, pg8::SplitTailOrder, PG8_ALIGN, PG8_SP2>(lds + RING_OFF, g, S, E, wave);
        if (!BOTH(8)) {} else VM_WAIT();
    }
    if (IN(9)) { PHASE_IDS;
        pg8::Gemm g{YB, WUPL, LW, LW, LW, 1 << 20, 0}; pg8::SplitTailOrder S; S.init(DM, LW / 64, G, bx);
        EpiUpLru E{MB, MPB, GT, SLAB2 + (size_t)256 * 65536, SLAB2};
        pg8::gemm_phase<EpiUpLru, pg8::SplitTailOrder, PG8_ALIGN, PG8_SP2>(lds + RING_OFF, g, S, E, wave);
        GRID_BAR();
        for (int i = gtid; i < 512 * 1024; i += NT) {
            const int row = 8192 + (i >> 10), col = (i & 1023) * 4;
            const float* sp = SLAB2 + (size_t)(256 + (((row - 8192) >> 8) * 16 + (col >> 8)) * 8) * 65536 + (size_t)(row & 255) * 256 + (col & 255);
            f32x4 a = *(const f32x4*)sp;
#pragma unroll
            for (int ks = 1; ks < 8; ++ks) a += *(const f32x4*)(sp + (size_t)ks * 65536);
            v2u w; w.x = pg8::cvt_pk_bf16(a.x, a.y); w.y = pg8::cvt_pk_bf16(a.z, a.w);
            *(v2u*)(MB + (size_t)row * DM + col) = w;
        }
        if (BOTH(9)) GRID_BAR();
    }
    if (IN(10)) { PHASE_IDS;
        pg8::Gemm g{MB, WOUT, DM, DM, DM, 1 << 20, 0}; pg8::SplitTailOrder S; S.init(DM, DM / 64, G, bx);
        EpiResid<1> E{VB, X1B, nullptr, nullptr, nullptr, 1.0f, SLAB};
        pg8::gemm_phase<EpiResid<1>, pg8::SplitTailOrder, PG8_ALIGN, PG8_SP2>(lds + RING_OFF, g, S, E, wave);
        if (BOTH(10)) GRID_BAR();
    }
    if (IN(11)) { PHASE_IDS;
        ln_rows<0, 1, true>(VB, SLAB, X1B, nullptr, nullptr, nullptr, 1.0f, args.in[25], args.in[26], out, XB, nullptr, gw, NGW, lane, X2Q, RS2);
        if (BOTH(11)) GRID_BAR();
    }
    if (IN(12)) { PHASE_IDS;
        pg8::Gemm g{(const bf16*)X2Q, WFA, DM / 2, DM / 2, DM / 2, 1 << 20, 0}; pg8::StaticOrder S; S.init(MPAD, 2 * DFF, G, bx);
        EpiSwigluI8 E{(unsigned char*)HB, RS2, CMAX2};
        pg8::gemm_phase<EpiSwigluI8, pg8::StaticOrder, PG8_ALIGN, PG8_SP2, 2>(lds + RING_OFF, g, S, E, wave);
        { const int tr = TAIL_RANK(34 * 86), tn = TAIL_WGS(34 * 86);
          if (tr >= 0) for (int it = tr * NWAVES + wave; it < 86 * 64; it += tn * NWAVES) { const int kb = it >> 6, nb = it & 63; tr_item8(args.in[28], DM, (unsigned char*)WFB, DFF, 128 * kb, 64 * nb, 64 * nb, scr, lane, 128.f); } }
        if (BOTH(12)) GRID_BAR();
    }
    if (IN(13)) { PHASE_IDS;
        pg8::Gemm g{HB, WFB, DFF / 2, DFF / 2, DFF / 2, 1 << 20, 0}; pg8::SplitTailOrder S; S.init(DM, DFF / 128, G, bx);
        EpiResid<1> E{VB, XB, nullptr, nullptr, nullptr, 0.5f / 512.f, SLAB};
        pg8::gemm_phase<EpiResid<1>, pg8::SplitTailOrder, PG8_ALIGN, PG8_SP2, true>(lds + RING_OFF, g, S, E, wave);
        if (BOTH(13)) GRID_BAR();
    }
    if (IN(14)) { PHASE_IDS;
        ln_rows<1, 1>(VB, SLAB, XB, nullptr, nullptr, nullptr, 0.5f / 512.f, args.in[29], args.in[30], nullptr, XB, out, gw, NGW, lane);
    }
#undef IN
#undef BOTH
#undef GRID_BAR
}

#ifndef MK_N_LAUNCHES
#define MK_N_LAUNCHES 1
#endif
extern "C" void kernel_launch(void* const* d_in, const int* in_sizes, int n_in, void* d_out, int out_size, void* d_ws, size_t ws_size, hipStream_t stream) {
    static int grid = 0;
    if (grid == 0) {
        if (n_in != 31 || (size_t)out_size != O_END || ws_size < WS_END) { fprintf(stderr, "kernel_launch: unexpected problem (n_in %d, out %d, ws %zu, need %zu); nothing launched\n", n_in, out_size, ws_size, (size_t)WS_END); grid = -1; return; }
        int dev = 0, cus = 0, per_cu = 0;
        if (hipGetDevice(&dev) != hipSuccess || hipDeviceGetAttribute(&cus, hipDeviceAttributeMultiprocessorCount, dev) != hipSuccess) { fprintf(stderr, "kernel_launch: device query failed\n"); grid = -1; return; }
        if (hipFuncSetAttribute((const void*)mk_fwd, hipFuncAttributeMaxDynamicSharedMemorySize, LDS_BYTES) != hipSuccess) { fprintf(stderr, "kernel_launch: hipFuncSetAttribute failed\n"); grid = -1; return; }
        if (hipOccupancyMaxActiveBlocksPerMultiprocessor(&per_cu, (const void*)mk_fwd, NWAVES * 64, LDS_BYTES) != hipSuccess || per_cu < 1)
            fprintf(stderr, "kernel_launch: note: occupancy query reports %d workgroups per CU\n", per_cu);
        (void)hipGetLastError();
        grid = cus;
    }
    if (grid < 0) return;
    if (hipMemsetAsync((char*)d_ws + WS_CTL, 0, CTL_ZERO_BYTES, stream) != hipSuccess) { fprintf(stderr, "kernel_launch: memset failed\n"); return; }
    Args a{};
    for (int i = 0; i < 31; ++i) a.in[i] = (const float*)d_in[i];
    a.out = (float*)d_out; a.ws = (unsigned char*)d_ws;
#if MK_N_LAUNCHES == 1
    a.ph_lo = 0; a.ph_hi = NPHASE; a.li = 0;
    hipLaunchKernelGGL(mk_fwd, dim3(grid), dim3(NWAVES * 64), LDS_BYTES, stream, a);
#else
    for (int li = 0; li < NPHASE; ++li) { a.ph_lo = li; a.ph_hi = li + 1; a.li = 0; hipLaunchKernelGGL(mk_fwd, dim3(grid), dim3(NWAVES * 64), LDS_BYTES, stream, a); }
#endif
    const hipError_t le = hipPeekAtLastError();
    if (le != hipSuccess) fprintf(stderr, "kernel_launch: launch failed: %s\n", hipGetErrorName(le));
}
```
